# Optimizing an MI355X kernel written in HIP

```python
import math
import jax, jax.numpy as jnp
from jax import lax
import numpy as np

D_MODEL = 1024
BATCH = 4
SEQ = 4096
DEPTH = 1

N_MEM = 256
D_MIX = D_MODEL
DN_HEADS = 4
DN_HEAD_DIM = 128
DN_WIDTH = DN_HEADS * DN_HEAD_DIM
CONV_WIDTH = 4
CHUNK = 64
S5_WIDTH = D_MIX - DN_WIDTH
S5_CH_PER_GROUP = 16
S5_GROUPS = S5_WIDTH // S5_CH_PER_GROUP
S5_STATE = 64
X_HEADS = 4
X_HEAD_DIM = D_MODEL // X_HEADS
D_FF = -(-8 * D_MODEL // (3 * 256)) * 256
EPS = 1e-6

OFF_Q = 0
OFF_K = OFF_Q + DN_WIDTH
OFF_V = OFF_K + DN_WIDTH
OFF_Z = OFF_V + DN_WIDTH
OFF_A = OFF_Z + DN_WIDTH
OFF_B = OFF_A + DN_HEADS
OFF_U = OFF_B + DN_HEADS
D_IN = OFF_U + S5_WIDTH

kernel_name = "hymba_deltanet_s5_memxattn_block"


def _rmsnorm(x, gain):
    x32 = x.astype(jnp.float32)
    y = x32 * lax.rsqrt(jnp.mean(x32 * x32, axis=-1, keepdims=True) + EPS)
    return (y * gain.astype(jnp.float32)).astype(x.dtype)


def _l2norm(x):
    return x * lax.rsqrt(jnp.sum(x * x, axis=-1, keepdims=True) + EPS)


def _causal_dwconv(x, w):
    c = x.shape[-1]
    return lax.conv_general_dilated(
        x, w.astype(x.dtype)[:, None, :], window_strides=(1,),
        padding=((CONV_WIDTH - 1, 0),),
        dimension_numbers=("NWC", "WIO", "NWC"), feature_group_count=c)


def _gated_delta_rule(q, k, v, g, beta):
    bsz, t, h, dk = q.shape
    dv = v.shape[-1]
    n = t // CHUNK

    def chunk(a):
        a = a.reshape((bsz, n, CHUNK, h) + a.shape[3:])
        return jnp.moveaxis(a, 3, 2)

    q, k, v, g, beta = chunk(q), chunk(k), chunk(v), chunk(g), chunk(beta)
    g_cum = jnp.cumsum(g, axis=-1)
    causal = jnp.tril(jnp.ones((CHUNK, CHUNK), dtype=bool))
    strict = jnp.tril(jnp.ones((CHUNK, CHUNK), dtype=bool), k=-1)
    decay = jnp.exp(jnp.where(causal, g_cum[..., :, None] - g_cum[..., None, :], -jnp.inf))

    kb = k * beta[..., None]
    lower = jnp.where(strict, jnp.einsum("bnhcd,bnhsd->bnhcs", kb, k) * decay, 0.0)
    tmat = jnp.eye(CHUNK, dtype=jnp.float32) + lower
    rhs = jnp.concatenate([v * beta[..., None], kb * jnp.exp(g_cum)[..., None]], axis=-1)
    sol = lax.linalg.triangular_solve(tmat, rhs, left_side=True, lower=True)
    u, w = sol[..., :dv], sol[..., dv:]

    attn = jnp.where(causal, jnp.einsum("bnhcd,bnhsd->bnhcs", q, k) * decay, 0.0)
    qg = q * jnp.exp(g_cum)[..., None]
    g_last = g_cum[..., -1]
    k_dec = k * jnp.exp(g_last[..., None] - g_cum)[..., None]
    a_last = jnp.exp(g_last)

    def step(s, inp):
        qg_c, kd_c, u_c, w_c, at_c, al_c = inp
        v_new = u_c - jnp.einsum("bhck,bhkv->bhcv", w_c, s)
        o_c = jnp.einsum("bhck,bhkv->bhcv", qg_c, s) + jnp.einsum("bhcs,bhsv->bhcv", at_c, v_new)
        s = s * al_c[..., None, None] + jnp.einsum("bhck,bhcv->bhkv", kd_c, v_new)
        return s, o_c

    xs = tuple(jnp.moveaxis(a, 1, 0) for a in (qg, k_dec, u, w, attn, a_last))
    s0 = jnp.zeros((bsz, h, dk, dv), jnp.float32)
    _, o = lax.scan(step, s0, xs)
    o = jnp.transpose(o, (1, 0, 3, 2, 4))
    return o.reshape(bsz, t, h, dv)


def _s5(u, a_re, a_im, b_re, b_im, c_re, c_im, d, log_dt):
    f = jnp.float32
    u = u.astype(f)
    a_re, a_im = a_re.astype(f), a_im.astype(f)
    b_re, b_im = b_re.astype(f), b_im.astype(f)
    dt = jnp.exp(log_dt.astype(f))[:, None]
    mag = jnp.exp(a_re * dt)
    ab_re, ab_im = mag * jnp.cos(a_im * dt), mag * jnp.sin(a_im * dt)
    den = a_re * a_re + a_im * a_im
    nr, ni = ab_re - 1.0, ab_im
    co_re = (nr * a_re + ni * a_im) / den
    co_im = (ni * a_re - nr * a_im) / den
    bb_re = co_re[..., None] * b_re - co_im[..., None] * b_im
    bb_im = co_re[..., None] * b_im + co_im[..., None] * b_re
    bu_re = jnp.einsum("btgc,gpc->tbgp", u, bb_re)
    bu_im = jnp.einsum("btgc,gpc->tbgp", u, bb_im)
    t = u.shape[1]
    la_re = jnp.broadcast_to(ab_re, (t, 1) + ab_re.shape)
    la_im = jnp.broadcast_to(ab_im, (t, 1) + ab_im.shape)

    def combine(e1, e2):
        a1r, a1i, b1r, b1i = e1
        a2r, a2i, b2r, b2i = e2
        return (a1r * a2r - a1i * a2i,
                a1r * a2i + a1i * a2r,
                a2r * b1r - a2i * b1i + b2r,
                a2r * b1i + a2i * b1r + b2i)

    _, _, x_re, x_im = lax.associative_scan(combine, (la_re, la_im, bu_re, bu_im), axis=0)
    y = (jnp.einsum("tbgp,gcp->btgc", x_re, c_re.astype(f))
         - jnp.einsum("tbgp,gcp->btgc", x_im, c_im.astype(f)))
    return y + d.astype(f) * u


def _mixer(xn, w_in, conv_w, dn_a_log, dn_dt_bias, dn_norm_g,
           s5_a_re, s5_a_im, s5_b_re, s5_b_im, s5_c_re, s5_c_im, s5_d, s5_log_dt,
           s5_w_glu, s5_b_glu, w_out):
    bsz, t, _ = xn.shape
    dt_ = xn.dtype
    proj = xn @ w_in

    qkv = jax.nn.silu(_causal_dwconv(proj[..., OFF_Q:OFF_Z], conv_w)).astype(jnp.float32)
    q = qkv[..., :DN_WIDTH].reshape(bsz, t, DN_HEADS, DN_HEAD_DIM)
    k = qkv[..., DN_WIDTH:2 * DN_WIDTH].reshape(bsz, t, DN_HEADS, DN_HEAD_DIM)
    v = qkv[..., 2 * DN_WIDTH:].reshape(bsz, t, DN_HEADS, DN_HEAD_DIM)
    q = _l2norm(q) * (DN_HEAD_DIM ** -0.5)
    k = _l2norm(k)
    z = proj[..., OFF_Z:OFF_A].astype(jnp.float32).reshape(bsz, t, DN_HEADS, DN_HEAD_DIM)
    a = proj[..., OFF_A:OFF_B].astype(jnp.float32)
    b = proj[..., OFF_B:OFF_U].astype(jnp.float32)
    g = -jnp.exp(dn_a_log.astype(jnp.float32)) * jax.nn.softplus(a + dn_dt_bias.astype(jnp.float32))
    beta = jax.nn.sigmoid(b)
    o = _gated_delta_rule(q, k, v, g, beta)
    o = o * lax.rsqrt(jnp.mean(o * o, axis=-1, keepdims=True) + EPS)
    o = o * dn_norm_g.astype(jnp.float32) * jax.nn.silu(z)
    o = o.reshape(bsz, t, DN_WIDTH).astype(dt_)

    u = proj[..., OFF_U:].reshape(bsz, t, S5_GROUPS, S5_CH_PER_GROUP)
    y = _s5(u, s5_a_re, s5_a_im, s5_b_re, s5_b_im, s5_c_re, s5_c_im, s5_d, s5_log_dt)
    y = jax.nn.gelu(y.reshape(bsz, t, S5_WIDTH)).astype(dt_)
    y = y * jax.nn.sigmoid(y @ s5_w_glu + s5_b_glu)

    return jnp.concatenate([o, y], axis=-1) @ w_out


def _cross_attn(hn, mem, norm_mem_g, w_xq, w_xk, w_xv, w_xo):
    bsz, t, _ = hn.shape
    mn = _rmsnorm(mem, norm_mem_g)
    q = (hn @ w_xq).reshape(bsz, t, X_HEADS, X_HEAD_DIM)
    k = (mn @ w_xk).reshape(bsz, N_MEM, X_HEADS, X_HEAD_DIM)
    v = (mn @ w_xv).reshape(bsz, N_MEM, X_HEADS, X_HEAD_DIM)
    s = jnp.einsum("bthd,bmhd->bhtm", q, k).astype(jnp.float32) * (X_HEAD_DIM ** -0.5)
    p = jax.nn.softmax(s, axis=-1).astype(hn.dtype)
    o = jnp.einsum("bhtm,bmhd->bthd", p, v).reshape(bsz, t, D_MODEL)
    return o @ w_xo


def _swiglu(hn, w_gate, w_up, w_down):
    return (jax.nn.silu(hn @ w_gate) * (hn @ w_up)) @ w_down


def setup_inputs(seed: int = 0) -> dict:
    key = jax.random.key(seed)
    ks = iter(jax.random.split(key, 40))
    nrm = lambda shape, scale: jax.random.normal(next(ks), shape, jnp.float32) * scale
    unif = lambda shape, lo, hi: jax.random.uniform(next(ks), shape, jnp.float32, lo, hi)
    L = DEPTH
    x = nrm((BATCH, SEQ, D_MODEL), 1.0)
    mem = nrm((BATCH, N_MEM, D_MODEL), 1.0)
    gain = lambda n: 1.0 + nrm((L, n), 0.02)
    dt_dn = jnp.exp(unif((L, DN_HEADS), math.log(1e-3), math.log(1e-1)))
    n_idx = jnp.arange(S5_STATE, dtype=jnp.float32)
    return {
        "x": x,
        "mem": mem,
        "norm_mix_g": gain(D_MODEL),
        "w_in": nrm((L, D_MODEL, D_IN), D_MODEL ** -0.5),
        "conv_w": nrm((L, CONV_WIDTH, 3 * DN_WIDTH), CONV_WIDTH ** -0.5),
        "dn_a_log": jnp.log(unif((L, DN_HEADS), 1.0, 16.0)),
        "dn_dt_bias": dt_dn + jnp.log(-jnp.expm1(-dt_dn)),
        "dn_norm_g": gain(DN_HEAD_DIM),
        "s5_a_re": -0.5 + nrm((L, S5_GROUPS, S5_STATE), 0.01),
        "s5_a_im": math.pi * n_idx + nrm((L, S5_GROUPS, S5_STATE), 0.01),
        "s5_b_re": nrm((L, S5_GROUPS, S5_STATE, S5_CH_PER_GROUP), (2 * S5_CH_PER_GROUP) ** -0.5),
        "s5_b_im": nrm((L, S5_GROUPS, S5_STATE, S5_CH_PER_GROUP), (2 * S5_CH_PER_GROUP) ** -0.5),
        "s5_c_re": nrm((L, S5_GROUPS, S5_CH_PER_GROUP, S5_STATE), (2 * S5_STATE) ** -0.5),
        "s5_c_im": nrm((L, S5_GROUPS, S5_CH_PER_GROUP, S5_STATE), (2 * S5_STATE) ** -0.5),
        "s5_d": nrm((L, S5_GROUPS, S5_CH_PER_GROUP), 1.0),
        "s5_log_dt": unif((L, S5_GROUPS), math.log(1e-3), math.log(1e-1)),
        "s5_w_glu": nrm((L, S5_WIDTH, S5_WIDTH), S5_WIDTH ** -0.5),
        "s5_b_glu": nrm((L, S5_WIDTH), 0.01),
        "w_out": nrm((L, D_MIX, D_MODEL), D_MIX ** -0.5),
        "norm_x_g": gain(D_MODEL),
        "norm_mem_g": gain(D_MODEL),
        "w_xq": nrm((L, D_MODEL, D_MODEL), D_MODEL ** -0.5),
        "w_xk": nrm((L, D_MODEL, D_MODEL), D_MODEL ** -0.5),
        "w_xv": nrm((L, D_MODEL, D_MODEL), D_MODEL ** -0.5),
        "w_xo": nrm((L, D_MODEL, D_MODEL), D_MODEL ** -0.5),
        "norm_ffn_g": gain(D_MODEL),
        "w_gate": nrm((L, D_MODEL, D_FF), D_MODEL ** -0.5),
        "w_up": nrm((L, D_MODEL, D_FF), D_MODEL ** -0.5),
        "w_down": nrm((L, D_FF, D_MODEL), D_FF ** -0.5),
        "norm_final_g": 1.0 + nrm((D_MODEL,), 0.02),
    }


def reference(x, mem, norm_mix_g, w_in, conv_w, dn_a_log, dn_dt_bias, dn_norm_g,
              s5_a_re, s5_a_im, s5_b_re, s5_b_im, s5_c_re, s5_c_im, s5_d, s5_log_dt,
              s5_w_glu, s5_b_glu, w_out, norm_x_g, norm_mem_g, w_xq, w_xk, w_xv, w_xo,
              norm_ffn_g, w_gate, w_up, w_down, norm_final_g):
    h = x
    for l in range(DEPTH):
        h = h + _mixer(_rmsnorm(h, norm_mix_g[l]), w_in[l], conv_w[l], dn_a_log[l],
                       dn_dt_bias[l], dn_norm_g[l], s5_a_re[l], s5_a_im[l], s5_b_re[l],
                       s5_b_im[l], s5_c_re[l], s5_c_im[l], s5_d[l], s5_log_dt[l],
                       s5_w_glu[l], s5_b_glu[l], w_out[l])
        h = h + _cross_attn(_rmsnorm(h, norm_x_g[l]), mem, norm_mem_g[l],
                            w_xq[l], w_xk[l], w_xv[l], w_xo[l])
        h = h + _swiglu(_rmsnorm(h, norm_ffn_g[l]), w_gate[l], w_up[l], w_down[l])
    return _rmsnorm(h, norm_final_g)
```

```cpp
#include <hip/hip_runtime.h>
#include <cstdio>
#include <cstdint>
#include <cmath>
namespace pg8 {
#define PG8_LAS __attribute__((address_space(3)))
typedef unsigned short bf16_t;
typedef short bf16x8 __attribute__((ext_vector_type(8)));
typedef float f32x4 __attribute__((ext_vector_type(4)));
typedef unsigned u32x4 __attribute__((ext_vector_type(4)));
constexpr int BM = 256, BK = 64, HALF = 128, HTB = HALF * BK * 2  , STAGE_BYTES = 8 * HTB, NXCD = 8, WGM = 8;

__host__ __device__ __forceinline__ int lds_byte(int r, int c) { const int st = (r >> 4) * 2 + (c >> 5), rr = r & 15, cc = c & 31, ob = rr * 64 + cc * 2; return st * 1024 + (ob ^ (((ob >> 9) & 1) << 5)); }
__host__ __device__ __forceinline__ void stage_rc(int b, int& R, int& C) { const int st = b / 1024, sb = b % 1024, swz = sb ^ (((sb >> 9) & 1) << 5); R = (st >> 1) * 16 + swz / 64; C = (st & 1) * 32 + (swz % 64) / 2; }
__host__ __device__ __forceinline__ int perm32(int rho) { const int n = rho >> 4, i = rho & 15; return 8 * (i >> 2) + 4 * n + (i & 3); }

struct Unit { int pm, pn; };
struct Gemm { const bf16_t* A; const bf16_t* Bt; int M, N, K; };

struct StaticOrder {
    int nM, nN, nwg, G, c;
    __host__ __device__ void init(int M, int N, int G_, int c_) { nM = M / BM; nN = N / BM; nwg = nM * nN; G = G_; c = c_; }
    __host__ __device__ bool next(int i, Unit& u) const {
        const long L = (long)i * G + c; if (L >= nwg) return false;
        int wgid = (int)L; { const int q = nwg / NXCD, r = nwg % NXCD, xcd = wgid % NXCD, off = wgid / NXCD; wgid = (xcd < r ? xcd * (q + 1) : r * (q + 1) + (xcd - r) * q) + off; }
        const int nig = WGM * nN, gid = wgid / nig, fm = gid * WGM, gsz = (nM - fm) < WGM ? (nM - fm) : WGM;
        u.pm = fm + ((wgid % nig) % gsz); u.pn = (wgid % nig) / gsz; return true;
    }
    __device__ __forceinline__ void a_ready(const Unit&) const {}
    __device__ __forceinline__ void done(const Unit&) const {}
};


__device__ __forceinline__ unsigned cvt_pk_bf16(float lo, float hi) { unsigned r; asm volatile("v_cvt_pk_bf16_f32 %0, %1, %2" : "=v"(r) : "v"(lo), "v"(hi)); return r; }
__device__ __forceinline__ float bf_lo(unsigned w) { return __builtin_bit_cast(float, w << 16); }
__device__ __forceinline__ float bf_hi(unsigned w) { return __builtin_bit_cast(float, w & 0xffff0000u); }
__device__ __forceinline__ u32x4 pack8(const f32x4 v0, const f32x4 v1) { u32x4 w; w.x = cvt_pk_bf16(v0[0], v0[1]); w.y = cvt_pk_bf16(v0[2], v0[3]); w.z = cvt_pk_bf16(v1[0], v1[1]); w.w = cvt_pk_bf16(v1[2], v1[3]); return w; }
__device__ __forceinline__ float sigmoid_f(float x) { return __builtin_amdgcn_rcpf(1.0f + __expf(-x)); }

struct EpiBf16 {
    static constexpr bool PERM = true, AFTER_DRAIN = false;
    bf16_t* O; int ldc;
    __device__ __forceinline__ void operator()(const f32x4 (&acc)[2][2][4][2], const Unit& u, int wr, int wc, int fr, int fq) const {
        const int row0 = u.pm * BM + wr * 64 + fr, col0 = u.pn * BM + wc * 32 + 8 * fq;
#pragma unroll
        for (int ai = 0; ai < 2; ++ai)
#pragma unroll
            for (int m = 0; m < 4; ++m) { bf16_t* rowp = O + (size_t)(row0 + ai * HALF + m * 16) * ldc + col0;
#pragma unroll
                for (int bj = 0; bj < 2; ++bj) *(u32x4*)(rowp + bj * HALF) = pack8(acc[ai][bj][m][0], acc[ai][bj][m][1]); }
    }
};
struct EpiProj {
    static constexpr bool PERM = true, AFTER_DRAIN = false;
    bf16_t* PROJ; bf16_t* KV;
    __device__ __forceinline__ void operator()(const f32x4 (&acc)[2][2][4][2], const Unit& u, int wr, int wc, int fr, int fq) const {
        const bool kv = u.pn >= 10; bf16_t* O = kv ? KV : PROJ; const int ldc = kv ? 2048 : 2560;
        const int row0 = (kv ? u.pm - 64 : u.pm) * BM + wr * 64 + fr, col0 = (kv ? u.pn - 10 : u.pn) * BM + wc * 32 + 8 * fq;
#pragma unroll
        for (int ai = 0; ai < 2; ++ai)
#pragma unroll
            for (int m = 0; m < 4; ++m) { bf16_t* rowp = O + (size_t)(row0 + ai * HALF + m * 16) * ldc + col0;
#pragma unroll
                for (int bj = 0; bj < 2; ++bj) *(u32x4*)(rowp + bj * HALF) = pack8(acc[ai][bj][m][0], acc[ai][bj][m][1]); }
    }
};
struct EpiGlu {
    static constexpr bool PERM = true, AFTER_DRAIN = false;
    const bf16_t* Y0; const float* bglu; bf16_t* OY;
    __device__ __forceinline__ void operator()(const f32x4 (&acc)[2][2][4][2], const Unit& u, int wr, int wc, int fr, int fq) const {
        const int row0 = u.pm * BM + wr * 64 + fr, col0 = u.pn * BM + wc * 32 + 8 * fq;
#pragma unroll
        for (int bj = 0; bj < 2; ++bj) { const int col = col0 + bj * HALF; const f32x4 b0 = *(const f32x4*)(bglu + col), b1 = *(const f32x4*)(bglu + col + 4);
#pragma unroll
            for (int ai = 0; ai < 2; ++ai)
#pragma unroll
                for (int m = 0; m < 4; ++m) { const size_t r = (size_t)(row0 + ai * HALF + m * 16); const u32x4 yw = *(const u32x4*)(Y0 + r * 512 + col);
                    f32x4 v0 = acc[ai][bj][m][0] + b0, v1 = acc[ai][bj][m][1] + b1;
                    v0[0] = bf_lo(yw.x) * sigmoid_f(v0[0]); v0[1] = bf_hi(yw.x) * sigmoid_f(v0[1]); v0[2] = bf_lo(yw.y) * sigmoid_f(v0[2]); v0[3] = bf_hi(yw.y) * sigmoid_f(v0[3]);
                    v1[0] = bf_lo(yw.z) * sigmoid_f(v1[0]); v1[1] = bf_hi(yw.z) * sigmoid_f(v1[1]); v1[2] = bf_lo(yw.w) * sigmoid_f(v1[2]); v1[3] = bf_hi(yw.w) * sigmoid_f(v1[3]);
                    *(u32x4*)(OY + r * 1024 + 512 + col) = pack8(v0, v1); } }
    }
};
struct EpiResid {
    static constexpr bool PERM = false, AFTER_DRAIN = false;
    const float* base; float* out;
    __device__ __forceinline__ void operator()(const f32x4 (&acc)[2][2][4][2], const Unit& u, int wr, int wc, int fr, int fq) const {
        const int row0 = u.pm * BM + wr * 64 + fr, col0 = u.pn * BM + wc * 32 + 4 * fq;
#pragma unroll
        for (int ai = 0; ai < 2; ++ai)
#pragma unroll
            for (int m = 0; m < 4; ++m) { const size_t off = (size_t)(row0 + ai * HALF + m * 16) * 1024 + col0;
#pragma unroll
                for (int bj = 0; bj < 2; ++bj)
#pragma unroll
                    for (int n = 0; n < 2; ++n) { const f32x4 bs = *(const f32x4*)(base + off + bj * HALF + n * 16); *(f32x4*)(out + off + bj * HALF + n * 16) = bs + acc[ai][bj][m][n]; } }
    }
};
struct EpiSwiGlu {
    static constexpr bool PERM = true, AFTER_DRAIN = false;
    bf16_t* HID;
    __device__ __forceinline__ void operator()(const f32x4 (&acc)[2][2][4][2], const Unit& u, int wr, int wc, int fr, int fq) const {
        const int row0 = u.pm * BM + wr * 64 + fr, col0 = u.pn * HALF + wc * 32 + 8 * fq;
#pragma unroll
        for (int ai = 0; ai < 2; ++ai)
#pragma unroll
            for (int m = 0; m < 4; ++m) { f32x4 v[2];
#pragma unroll
                for (int n = 0; n < 2; ++n)
#pragma unroll
                    for (int j = 0; j < 4; ++j) { const float g = acc[ai][0][m][n][j]; v[n][j] = g * sigmoid_f(g) * acc[ai][1][m][n][j]; }
                *(u32x4*)(HID + (size_t)(row0 + ai * HALF + m * 16) * 2816 + col0) = pack8(v[0], v[1]); }
    }
};
template <class Epi, class Sched, bool ALIGN_EPI = false, bool SP2 = false>
__device__ __forceinline__ void gemm_phase(PG8_LAS unsigned char* lds, const Gemm g, const Sched& S, const Epi& E) {
    const int tid = threadIdx.x, wid = __builtin_amdgcn_readfirstlane(tid >> 6), lane = tid & 63, wr = wid >> 2, wc = wid & 3, fr = lane & 15, fq = lane >> 4;
    const int K = g.K, nt = K / BK;
    unsigned voffA[2], voffB[2];
#pragma unroll
    for (int i = 0; i < 2; ++i) { int R, C; stage_rc(tid * 16 + i * 8192, R, C); const int Rb = Epi::PERM ? ((R & ~31) + perm32(R & 31)) : R;
        voffA[i] = (unsigned)(R * K + C) * 2u; voffB[i] = (unsigned)(Rb * K + C) * 2u; }
    const size_t kstep = (size_t)(BK * 2);
    const size_t hstep = (size_t)HALF * K * 2;
    const size_t tstep = 2 * hstep;
    const unsigned ldsw = (unsigned)wid * 1024u;
    const int aoff = lds_byte(wr * 64 + fr, fq * 8), boff = lds_byte(wc * 32 + fr, fq * 8);
#define PG8_SA(b, h) (((b) * 2 + (h)) * HTB)
#define PG8_SB(b, h) ((4 + (b) * 2 + (h)) * HTB)
#define PG8_STAGE(bufoff, gbase, voff) do { _Pragma("unroll") for (int _i = 0; _i < 2; ++_i) \
        __builtin_amdgcn_global_load_lds((const unsigned*)((const char*)(gbase) + (voff)[_i]), (PG8_LAS unsigned*)(lds + (bufoff) + ldsw + _i * 8192), 16, 0, 0); } while (0)
#define PG8_LDA(dst, b, h) do { _Pragma("unroll") for (int m = 0; m < 4; ++m) _Pragma("unroll") for (int k = 0; k < 2; ++k) dst[m][k] = *(const PG8_LAS bf16x8*)(lds + PG8_SA(b, h) + aoff + m * 2048 + k * 1024); } while (0)
#define PG8_LDB(dst, b, h) do { _Pragma("unroll") for (int n = 0; n < 2; ++n) _Pragma("unroll") for (int k = 0; k < 2; ++k) dst[n][k] = *(const PG8_LAS bf16x8*)(lds + PG8_SB(b, h) + boff + n * 2048 + k * 1024); } while (0)
#define PG8_MMA(ai, bj, At, Bt) do { __builtin_amdgcn_s_setprio(1); _Pragma("unroll") for (int m = 0; m < 4; ++m) _Pragma("unroll") for (int n = 0; n < 2; ++n) _Pragma("unroll") for (int k = 0; k < 2; ++k) \
        acc[ai][bj][m][n] = __builtin_amdgcn_mfma_f32_16x16x32_bf16(Bt[n][k], At[m][k], acc[ai][bj][m][n], 0, 0, 0); __builtin_amdgcn_s_setprio(0); } while (0)
#define PG8_WAIT_V(n) asm volatile("s_waitcnt vmcnt(" #n ")" ::: "memory")
#define PG8_WAIT_L(n) asm volatile("s_waitcnt lgkmcnt(" #n ")" ::: "memory")
#define PG8_BAR __builtin_amdgcn_s_barrier()
#define PG8_SCHED __builtin_amdgcn_sched_barrier(0)
    Unit cur, nxt; int ui = 0;
    if (!S.next(0, cur)) return;
    f32x4 acc[2][2][4][2];
#pragma unroll
    for (int a = 0; a < 2; ++a)
#pragma unroll
        for (int b = 0; b < 2; ++b)
#pragma unroll
            for (int m = 0; m < 4; ++m)
#pragma unroll
                for (int n = 0; n < 2; ++n) acc[a][b][m][n] = (f32x4){0.f, 0.f, 0.f, 0.f};
    bf16x8 At[4][2], B0[2][2], B1[2][2];
    const char* cA = (const char*)g.A + (size_t)cur.pm * tstep; const char* cB = (const char*)g.Bt + (size_t)cur.pn * tstep;
    S.a_ready(cur);
    if constexpr (SP2) {
        PG8_STAGE(PG8_SB(0, 0), cB, voffB); PG8_STAGE(PG8_SB(0, 1), cB + hstep, voffB); PG8_STAGE(PG8_SA(0, 0), cA, voffA); PG8_STAGE(PG8_SA(0, 1), cA + hstep, voffA);
        if (wr == 1) PG8_BAR;
        PG8_WAIT_V(2); PG8_BAR;
        PG8_STAGE(PG8_SB(1, 0), cB + kstep, voffB); PG8_STAGE(PG8_SA(1, 0), cA + kstep, voffA); PG8_STAGE(PG8_SB(1, 1), cB + hstep + kstep, voffB);
        PG8_WAIT_V(6); PG8_BAR;
    } else {
        PG8_STAGE(PG8_SB(0, 0), cB, voffB); PG8_STAGE(PG8_SA(0, 0), cA, voffA); PG8_STAGE(PG8_SB(0, 1), cB + hstep, voffB); PG8_STAGE(PG8_SA(0, 1), cA + hstep, voffA);
        if (wr == 1) PG8_BAR;
        PG8_WAIT_V(4); PG8_BAR;
        PG8_STAGE(PG8_SB(1, 0), cB + kstep, voffB); PG8_STAGE(PG8_SA(1, 0), cA + kstep, voffA); PG8_STAGE(PG8_SB(1, 1), cB + hstep + kstep, voffB);
        PG8_WAIT_V(6); PG8_BAR;
    }
    for (;;) {
        const bool has_next = S.next(ui + 1, nxt);
        const char* nA = has_next ? (const char*)g.A + (size_t)nxt.pm * tstep : cA; const char* nB = has_next ? (const char*)g.Bt + (size_t)nxt.pn * tstep : cB;
        for (int t = 0; t < nt; t += 2) {
            const bool last = (t == nt - 2);
            const char* a1 = cA + (size_t)(t + 1) * kstep;
            const char* a2 = last ? nA : cA + (size_t)(t + 2) * kstep; const char* b2 = last ? nB : cB + (size_t)(t + 2) * kstep;
            const char* a3 = a2 + kstep; const char* b3 = b2 + kstep;
            if (last && has_next) S.a_ready(nxt);
            if constexpr (SP2) {
            PG8_LDB(B0, 0, 0); PG8_LDB(B1, 0, 1); PG8_SCHED; PG8_LDA(At, 0, 0); PG8_STAGE(PG8_SA(1, 1), a1 + hstep, voffA);
            PG8_WAIT_V(8); PG8_WAIT_L(0); PG8_BAR; PG8_MMA(0, 0, At, B0); PG8_MMA(0, 1, At, B1); PG8_BAR; PG8_SCHED;
            PG8_LDA(At, 0, 1); PG8_STAGE(PG8_SB(0, 0), b2, voffB); PG8_STAGE(PG8_SB(0, 1), b2 + hstep, voffB); PG8_STAGE(PG8_SA(0, 0), a2, voffA);
            PG8_WAIT_V(8); PG8_WAIT_L(0); PG8_BAR; PG8_MMA(1, 0, At, B0); PG8_MMA(1, 1, At, B1); PG8_BAR; PG8_SCHED;
            PG8_LDB(B0, 1, 0); PG8_LDB(B1, 1, 1); PG8_SCHED; PG8_LDA(At, 1, 0); PG8_STAGE(PG8_SA(0, 1), a2 + hstep, voffA);
            PG8_WAIT_V(8); PG8_WAIT_L(0); PG8_BAR; PG8_MMA(0, 0, At, B0); PG8_MMA(0, 1, At, B1); PG8_BAR; PG8_SCHED;
            PG8_LDA(At, 1, 1); PG8_STAGE(PG8_SB(1, 0), b3, voffB); PG8_STAGE(PG8_SB(1, 1), b3 + hstep, voffB); PG8_STAGE(PG8_SA(1, 0), a3, voffA);
            PG8_WAIT_V(8); PG8_WAIT_L(0); PG8_BAR; PG8_MMA(1, 0, At, B0); PG8_MMA(1, 1, At, B1); PG8_BAR; PG8_SCHED;
            } else {
            PG8_LDB(B0, 0, 0); PG8_SCHED; PG8_LDA(At, 0, 0); PG8_STAGE(PG8_SA(1, 1), a1 + hstep, voffA);
            PG8_WAIT_L(8); PG8_BAR; PG8_WAIT_L(0); PG8_MMA(0, 0, At, B0); PG8_BAR; PG8_SCHED;
            PG8_LDB(B1, 0, 1); PG8_STAGE(PG8_SB(0, 0), b2, voffB);
            PG8_BAR; PG8_WAIT_L(0); PG8_MMA(0, 1, At, B1); PG8_BAR;
            PG8_LDA(At, 0, 1); PG8_STAGE(PG8_SA(0, 0), a2, voffA);
            PG8_BAR; PG8_WAIT_L(0); PG8_MMA(1, 0, At, B0); PG8_BAR; PG8_SCHED;
            PG8_STAGE(PG8_SB(0, 1), b2 + hstep, voffB);
            PG8_WAIT_V(6); PG8_BAR; PG8_MMA(1, 1, At, B1); PG8_BAR;
            PG8_LDB(B0, 1, 0); PG8_SCHED; PG8_LDA(At, 1, 0); PG8_STAGE(PG8_SA(0, 1), a2 + hstep, voffA);
            PG8_WAIT_L(8); PG8_BAR; PG8_WAIT_L(0); PG8_MMA(0, 0, At, B0); PG8_BAR; PG8_SCHED;
            PG8_LDB(B1, 1, 1); PG8_STAGE(PG8_SB(1, 0), b3, voffB);
            PG8_BAR; PG8_WAIT_L(0); PG8_MMA(0, 1, At, B1); PG8_BAR;
            PG8_LDA(At, 1, 1); PG8_STAGE(PG8_SA(1, 0), a3, voffA);
            PG8_BAR; PG8_WAIT_L(0); PG8_MMA(1, 0, At, B0); PG8_BAR; PG8_SCHED;
            PG8_STAGE(PG8_SB(1, 1), b3 + hstep, voffB);
            PG8_WAIT_V(6); PG8_BAR; PG8_MMA(1, 1, At, B1); PG8_BAR;
            }
        }
        if constexpr (ALIGN_EPI) { if (wr == 0) PG8_BAR; }
        if constexpr (!Epi::AFTER_DRAIN) { E(acc, cur, wr, wc, fr, fq); S.done(cur); }
        if (!has_next) break;
#pragma unroll
        for (int a = 0; a < 2; ++a)
#pragma unroll
            for (int b = 0; b < 2; ++b)
#pragma unroll
                for (int m = 0; m < 4; ++m)
#pragma unroll
                    for (int n = 0; n < 2; ++n) acc[a][b][m][n] = (f32x4){0.f, 0.f, 0.f, 0.f};
        cur = nxt; cA = nA; cB = nB; ++ui;
        if constexpr (ALIGN_EPI) { if (wr == 1) PG8_BAR; }
    }
    PG8_WAIT_V(0);
    if constexpr (!ALIGN_EPI) { if (wr == 0) PG8_BAR; }
    PG8_BAR;
    if constexpr (Epi::AFTER_DRAIN) { E.fused(acc, cur, wr, wc, fr, fq, lds, wid, lane); S.done(cur); }
#undef PG8_SA
#undef PG8_SB
#undef PG8_STAGE
#undef PG8_LDA
#undef PG8_LDB
#undef PG8_MMA
#undef PG8_WAIT_V
#undef PG8_WAIT_L
#undef PG8_BAR
#undef PG8_SCHED
}
}

constexpr int NWAVES = 8;
#ifndef MK_N_LAUNCHES
#define MK_N_LAUNCHES 1
#endif
constexpr int PER_PHASE = 14;
constexpr int N_LAUNCHES = MK_N_LAUNCHES;

constexpr int BATCH = 4, T = 4096, D = 1024, M = BATCH * T, NMEM = 256;
constexpr int DIN = 2568, NPROJ = 2560, DFF = 2816, NGU = 2 * DFF;
constexpr float EPS = 1e-6f;

constexpr size_t MiB = 1u << 20;
constexpr size_t WS_CTL = 0, CTL_ZERO_BYTES = 1 * MiB;
constexpr size_t WS_WIN = 1 * MiB;
constexpr size_t WS_WKV = 6 * MiB;
constexpr size_t WS_WGLU = 10 * MiB;
constexpr size_t WS_WOUT = 10 * MiB + 512 * 1024;
constexpr size_t WS_WXQ = WS_WOUT + 2 * MiB, WS_WXO = WS_WXQ + 2 * MiB;
constexpr size_t WS_WGU = WS_WXO + 2 * MiB;
constexpr size_t WS_WDN = WS_WGU + 11 * MiB;
constexpr size_t WS_XN = 33 * MiB;
constexpr size_t WS_MN = 65 * MiB;
constexpr size_t WS_PROJ = 67 * MiB;
constexpr size_t WS_KV = 147 * MiB;
constexpr size_t WS_KT = 151 * MiB, WS_VT = 153 * MiB;
constexpr size_t WS_AB = 155 * MiB;
constexpr size_t WS_GB = 155 * MiB + 512 * 1024;
constexpr size_t WS_OY = 156 * MiB;
constexpr size_t WS_Y0 = 188 * MiB;
constexpr size_t WS_QKVP = 204 * MiB;
constexpr size_t WS_QB = 67 * MiB, WS_AO = 99 * MiB;
constexpr size_t WS_HID = 67 * MiB;
constexpr size_t WS_END = 256 * MiB;
static_assert(WS_WDN + (size_t)D * DFF * 2 <= WS_XN && WS_QKVP + (size_t)M * 1536 * 2 <= WS_END && WS_HID + (size_t)M * DFF * 2 <= WS_OY + 32 * MiB, "d_ws map");
constexpr int CW_TMO = 0, CW_CODE = 1;
constexpr int CW_BAR = 4096;

constexpr int RING_OFF = 0, RING_BYTES = 131072;
constexpr int LDSCTL_OFF = RING_BYTES, MISC_OFF = LDSCTL_OFF + 320;
constexpr int LDS_BYTES = 147456;
static_assert(MISC_OFF + 128 <= LDS_BYTES, "LDS map");
#define GAS __attribute__((address_space(1)))
#define LAS __attribute__((address_space(3)))
typedef unsigned short bf16;
typedef unsigned v4u __attribute__((ext_vector_type(4)));
typedef float f32x4 __attribute__((ext_vector_type(4)));
typedef short bf16x8 __attribute__((ext_vector_type(8)));
typedef GAS unsigned gu32;
typedef GAS unsigned long long gu64;
#define RLX_AGENT __ATOMIC_RELAXED, __HIP_MEMORY_SCOPE_AGENT
#define LDS_WAIT() asm volatile("s_waitcnt lgkmcnt(0)" ::: "memory")
#define VM_WAIT() asm volatile("s_waitcnt vmcnt(0)" ::: "memory")
__device__ __forceinline__ unsigned long long rt() { return __builtin_amdgcn_s_memrealtime(); }
__device__ __forceinline__ unsigned f2bf(float f) { unsigned u = __builtin_bit_cast(unsigned, f); return (u + 0x7fffu + ((u >> 16) & 1u)) >> 16; }
__device__ __forceinline__ unsigned pk2(float lo, float hi) { return f2bf(lo) | (f2bf(hi) << 16); }

#define XB_TMO      128
#define XB_XCNT(j)  (256  + 64 * (j))
#define XB_XSUB(j)  (1280 + 64 * (j))
#define XB_XGEN(j)  (2304 + 64 * (j))
#define XB_TOP      3328
#define XB_TOPGEN   3392
#define XCD_BAR_WORDS 3456
#define XB_SPIN_CAP (1u << 18)

__device__ __forceinline__ unsigned xb_ld(unsigned* p)              { return __hip_atomic_load(p, __ATOMIC_RELAXED, __HIP_MEMORY_SCOPE_AGENT); }
__device__ __forceinline__ unsigned xb_add(unsigned* p, unsigned v) { return __hip_atomic_fetch_add(p, v, __ATOMIC_RELAXED, __HIP_MEMORY_SCOPE_AGENT); }
__device__ __forceinline__ unsigned xb_xcc_id() { return (unsigned)__builtin_amdgcn_s_getreg((3 << 11) | 20) & 0xFu; }
#define XB_SPIN(cond, bar) do { unsigned _sp = 0; while (cond) { __builtin_amdgcn_s_sleep(1); \
    if ((++_sp & 255u) == 0u) { if (xb_ld(&(bar)[XB_TMO])) break; if (_sp > XB_SPIN_CAP) { atomicAdd(&(bar)[XB_TMO], 1u); break; } } } } while (0)

struct XcdBarrier {
    unsigned* bar; unsigned x;
    volatile LAS unsigned* st;
};

__device__ __forceinline__ XcdBarrier xcd_barrier_post(unsigned* bar, volatile LAS unsigned* st) {
    XcdBarrier b; b.bar = bar; b.x = xb_xcc_id(); b.st = st;
    if (threadIdx.x == 0) (void)xb_add(&bar[XB_XCNT(b.x)], 1u);
    return b;
}
__device__ __forceinline__ void xcd_barrier_complete(unsigned* bar, unsigned x, unsigned& nloc, unsigned& nx) {
    const unsigned G = gridDim.x * gridDim.y * gridDim.z;
    unsigned sum, cnt, mine, sp = 0u;
    for (;;) {
        sum = 0u; cnt = 0u; mine = 0u;
#pragma unroll
        for (unsigned j = 0; j < 16; ++j) { const unsigned c = xb_ld(&bar[XB_XCNT(j)]); sum += c; cnt += (c > 0u) ? 1u : 0u; mine = (j == x) ? c : mine; }
        if (sum == G) break;
        __builtin_amdgcn_s_sleep(1);
        if ((++sp & 255u) == 0u) { if (xb_ld(&bar[XB_TMO])) break; if (sp > XB_SPIN_CAP) { atomicAdd(&bar[XB_TMO], 1u); break; } }
    }
    nloc = mine > 0u ? mine : 1u; nx = cnt > 0u ? cnt : 1u;
}

__device__ __forceinline__ void xcd_barrier(const XcdBarrier& b) {
    asm volatile("s_waitcnt vmcnt(0)" ::: "memory");
    __syncthreads();
    if (threadIdx.x == 0) {
        unsigned* bar = b.bar;
        __builtin_amdgcn_s_waitcnt(0);
        unsigned nloc = b.st[0], nx = b.st[1];
        if (nloc == 0u) { xcd_barrier_complete(bar, b.x, nloc, nx); b.st[0] = nloc; b.st[1] = nx; }
        const unsigned old = xb_add(&bar[XB_XSUB(b.x)], 1u);
        const unsigned gen = old / nloc;
        if (old + 1u == (gen + 1u) * nloc) {
            __builtin_amdgcn_fence(__ATOMIC_RELEASE, "agent");
            asm volatile("s_waitcnt vmcnt(0)" ::: "memory");
            const unsigned og = xb_add(&bar[XB_TOP], 1u);
            const unsigned tg = og / nx;
            if (og + 1u == (tg + 1u) * nx) xb_add(&bar[XB_TOPGEN], 1u);
            else XB_SPIN(xb_ld(&bar[XB_TOPGEN]) == tg, bar);
            __builtin_amdgcn_fence(__ATOMIC_ACQUIRE, "agent");
            xb_add(&bar[XB_XGEN(b.x)], 1u);
            asm volatile("s_waitcnt vmcnt(0)" ::: "memory");
        } else {
            XB_SPIN(xb_ld(&bar[XB_XGEN(b.x)]) == gen, bar);
            __builtin_amdgcn_fence(__ATOMIC_ACQUIRE, "agent");
            asm volatile("s_waitcnt vmcnt(0)" ::: "memory");
        }
    }
    __syncthreads();
}

typedef unsigned v2u __attribute__((ext_vector_type(2)));
__device__ __forceinline__ float wave_sum(float v) {
#pragma unroll
    for (int o = 1; o < 64; o <<= 1) v += __shfl_xor(v, o);
    return v;
}
__device__ __forceinline__ float wave_max(float v) {
#pragma unroll
    for (int o = 1; o < 64; o <<= 1) v = fmaxf(v, __shfl_xor(v, o));
    return v;
}
__device__ __forceinline__ float bflo(unsigned w) { return __builtin_bit_cast(float, w << 16); }
__device__ __forceinline__ float bfhi(unsigned w) { return __builtin_bit_cast(float, w & 0xffff0000u); }
__device__ __forceinline__ float bf1(bf16 h) { return __builtin_bit_cast(float, (unsigned)h << 16); }
__device__ __forceinline__ float silu_f(float x) { return x / (1.0f + __expf(-x)); }

__device__ __forceinline__ void transpose_item(const float* W, int ldw, int k0, int c0, bf16* WT, int Kd, int r0, LAS float* scr, int lane) {
#pragma unroll 8
    for (int i = 0; i < 32; ++i) { const int kk = 2 * i + (lane >> 5); scr[kk * 33 + (lane & 31)] = W[(size_t)(k0 + kk) * ldw + c0 + (lane & 31)]; }
    LDS_WAIT(); asm volatile("" ::: "memory");
    const int c = lane & 7;
#pragma unroll
    for (int j = 0; j < 4; ++j) { const int n = (lane >> 3) + 8 * j; const LAS float* s = scr + (8 * c) * 33 + n;
        v4u o; o.x = pk2(s[0 * 33], s[1 * 33]); o.y = pk2(s[2 * 33], s[3 * 33]); o.z = pk2(s[4 * 33], s[5 * 33]); o.w = pk2(s[6 * 33], s[7 * 33]);
        *(GAS v4u*)(WT + (size_t)(r0 + n) * Kd + k0 + 8 * c) = o; }
    LDS_WAIT(); asm volatile("" ::: "memory");
}
__device__ __forceinline__ void rms_row(const float* xrow, const float* gain, bf16* orow, int lane, f32x4 (&vn)[4]) {
    const GAS f32x4* xr = (const GAS f32x4*)xrow + lane; const GAS f32x4* gr = (const GAS f32x4*)gain + lane;
    float s = 0.f;
#pragma unroll
    for (int j = 0; j < 4; ++j) { vn[j] = xr[64 * j]; s += (vn[j].x * vn[j].x + vn[j].y * vn[j].y) + (vn[j].z * vn[j].z + vn[j].w * vn[j].w); }
    const float r = 1.0f / sqrtf(wave_sum(s) * (1.f / 1024.f) + EPS);
    GAS v2u* o8 = (GAS v2u*)orow + lane;
#pragma unroll
    for (int j = 0; j < 4; ++j) { const f32x4 g = gr[64 * j]; vn[j] = vn[j] * r * g; v2u w; w.x = pk2(vn[j].x, vn[j].y); w.y = pk2(vn[j].z, vn[j].w); o8[64 * j] = w; }
}

__device__ __forceinline__ void p0_prologue(LAS unsigned char* lds, const float* const* in, unsigned char* ws, int gw, int NGW, int tid, int lane, int wave) {
    LAS float* scr = (LAS float*)(lds + RING_OFF + wave * 8704);
    LAS float* wab = (LAS float*)(lds + RING_OFF + 8 * 8704);
    const float* w_in = in[3];
    for (int idx = tid; idx < 8192; idx += NWAVES * 64) { const int c = idx & 7, k = idx >> 3; wab[c * 1024 + k] = w_in[(size_t)k * DIN + 2048 + c]; }
    constexpr int I_IN = 16 * 80, I_SQ = 16 * 32, I_GLU = 8 * 16, I_G = 16 * 88, I_DN = 44 * 32;
    constexpr int NITEMS = I_IN + 2 * I_SQ + I_GLU + 3 * I_SQ + 2 * I_G + I_DN;
    for (int it = gw; it < NITEMS; it += NGW) {
        int r = it;
        if (r < I_IN) { const int kb = r / 80, nb = r % 80; transpose_item(w_in, DIN, 64 * kb, 32 * nb + (nb >= 64 ? 8 : 0), (bf16*)(ws + WS_WIN), 1024, 32 * nb, scr, lane); continue; } r -= I_IN;
        if (r < I_SQ) { const int kb = r / 32, nb = r % 32; transpose_item(in[22], 1024, 64 * kb, 32 * nb, (bf16*)(ws + WS_WKV), 1024, 32 * nb, scr, lane); continue; } r -= I_SQ;
        if (r < I_SQ) { const int kb = r / 32, nb = r % 32; transpose_item(in[23], 1024, 64 * kb, 32 * nb, (bf16*)(ws + WS_WKV), 1024, 1024 + 32 * nb, scr, lane); continue; } r -= I_SQ;
        if (r < I_GLU) { const int kb = r / 16, nb = r % 16; transpose_item(in[16], 512, 64 * kb, 32 * nb, (bf16*)(ws + WS_WGLU), 512, 32 * nb, scr, lane); continue; } r -= I_GLU;
        if (r < I_SQ) { const int kb = r / 32, nb = r % 32; transpose_item(in[18], 1024, 64 * kb, 32 * nb, (bf16*)(ws + WS_WOUT), 1024, 32 * nb, scr, lane); continue; } r -= I_SQ;
        if (r < I_SQ) { const int kb = r / 32, nb = r % 32; transpose_item(in[21], 1024, 64 * kb, 32 * nb, (bf16*)(ws + WS_WXQ), 1024, 32 * nb, scr, lane); continue; } r -= I_SQ;
        if (r < I_SQ) { const int kb = r / 32, nb = r % 32; transpose_item(in[24], 1024, 64 * kb, 32 * nb, (bf16*)(ws + WS_WXO), 1024, 32 * nb, scr, lane); continue; } r -= I_SQ;
        if (r < I_G) { const int kb = r / 88, nb = r % 88; transpose_item(in[26], DFF, 64 * kb, 32 * nb, (bf16*)(ws + WS_WGU), 1024, 256 * (nb >> 2) + 32 * (nb & 3), scr, lane); continue; } r -= I_G;
        if (r < I_G) { const int kb = r / 88, nb = r % 88; transpose_item(in[27], DFF, 64 * kb, 32 * nb, (bf16*)(ws + WS_WGU), 1024, 256 * (nb >> 2) + 128 + 32 * (nb & 3), scr, lane); continue; } r -= I_G;
        { const int kb = r / 32, nb = r % 32; transpose_item(in[28], 1024, 64 * kb, 32 * nb, (bf16*)(ws + WS_WDN), DFF, 32 * nb, scr, lane); }
    }
    __syncthreads();
    float* AB = (float*)(ws + WS_AB);
    for (int m = gw; m < M + BATCH * NMEM; m += NGW) {
        f32x4 vn[4];
        if (m < M) {
            rms_row(in[0] + (size_t)m * D, in[2], (bf16*)(ws + WS_XN) + (size_t)m * D, lane, vn);
#pragma unroll
            for (int c = 0; c < 8; ++c) { float p = 0.f;
#pragma unroll
                for (int j = 0; j < 4; ++j) { const f32x4 w = *(const LAS f32x4*)(wab + c * 1024 + 4 * lane + 256 * j); p += (vn[j].x * w.x + vn[j].y * w.y) + (vn[j].z * w.z + vn[j].w * w.w); }
                p = wave_sum(p); if (lane == 0) AB[(size_t)m * 8 + c] = p; }
        } else rms_row(in[1] + (size_t)(m - M) * D, in[20], (bf16*)(ws + WS_MN) + (size_t)(m - M) * D, lane, vn);
    }
}

struct ProjOrder {
    pg8::StaticOrder so; int G, c;
    __device__ void init(int G_, int c_) { so.init(M, NPROJ, G_, c_); G = G_; c = c_; }
    __device__ bool next(int i, pg8::Unit& u) const {
        long L = (long)i * G + c; if (L < 640) return so.next(i, u);
        L -= 640; if (L >= 32) return false; u.pm = 64 + (int)(L & 3); u.pn = 10 + (int)(L >> 2); return true;
    }
    __device__ __forceinline__ void a_ready(const pg8::Unit&) const {}
    __device__ __forceinline__ void done(const pg8::Unit&) const {}
};

__device__ __forceinline__ void p2a_prep(const float* const* in, unsigned char* ws, int gw, int NGW, int lane) {
    const bf16* PROJ = (const bf16*)(ws + WS_PROJ); bf16* QKVP = (bf16*)(ws + WS_QKVP);
    {
        const bf16* KV = (const bf16*)(ws + WS_KV);
        for (int cw = gw; cw < 2 * 16 * 32 * 4; cw += NGW) {
            const int d = (cw & 3) * 64 + lane, kb = (cw >> 2) & 31, bh = (cw >> 7) & 15, which = cw >> 11;
            const bf16* src = KV + (size_t)((bh >> 2) * 256 + kb * 8) * 2048 + which * 1024 + (bh & 3) * 256 + d;
            unsigned short e[8];
#pragma unroll
            for (int i = 0; i < 8; ++i) e[i] = src[(size_t)i * 2048];
            v4u o; o.x = e[0] | ((unsigned)e[1] << 16); o.y = e[2] | ((unsigned)e[3] << 16); o.z = e[4] | ((unsigned)e[5] << 16); o.w = e[6] | ((unsigned)e[7] << 16);
            *(GAS v4u*)((bf16*)(ws + (which ? WS_VT : WS_KT)) + (size_t)(bh * 256 + d) * 256 + kb * 8) = o;
        }
    }
    const float* conv_w = in[4]; const float* AB = (const float*)(ws + WS_AB); float* GB = (float*)(ws + WS_GB);
    for (int m = gw; m < M; m += NGW) {
        const int t = m & (T - 1);
#pragma unroll
        for (int j = 0; j < 6; ++j) {
            const int ch = 256 * j + 4 * lane; f32x4 a = {0.f, 0.f, 0.f, 0.f};
#pragma unroll
            for (int jj = 0; jj < 4; ++jj) { const int tt = t - 3 + jj;
                if (tt >= 0) { const v2u xw = *(const GAS v2u*)(PROJ + (size_t)(m - 3 + jj) * NPROJ + ch); const f32x4 w = *(const GAS f32x4*)(conv_w + jj * 1536 + ch);
                    a.x += w.x * bflo(xw.x); a.y += w.y * bfhi(xw.x); a.z += w.z * bflo(xw.y); a.w += w.w * bfhi(xw.y); } }
            a.x = silu_f(a.x); a.y = silu_f(a.y); a.z = silu_f(a.z); a.w = silu_f(a.w);
            if (j < 4) { float ss = (a.x * a.x + a.y * a.y) + (a.z * a.z + a.w * a.w);
#pragma unroll
                for (int o = 1; o < 32; o <<= 1) ss += __shfl_xor(ss, o);
                float r = 1.0f / sqrtf(ss + EPS); if (j < 2) r *= 0.08838834764831845f; a = a * r; }
            v2u w; w.x = pk2(a.x, a.y); w.y = pk2(a.z, a.w); *(GAS v2u*)(QKVP + (size_t)m * 1536 + ch) = w;
        }
        if (lane < 4) { const float a = AB[(size_t)m * 8 + lane], b = AB[(size_t)m * 8 + 4 + lane];
            const float x = a + in[6][lane]; const float sp = fmaxf(x, 0.f) + log1pf(expf(-fabsf(x)));
            GB[(size_t)m * 8 + lane] = -expf(in[5][lane]) * sp; GB[(size_t)m * 8 + 4 + lane] = 1.0f / (1.0f + expf(-b)); }
    }
}

struct DnIn { v4u q[4], k[4]; float v, g, beta; };
__device__ __forceinline__ void dn_load(DnIn& d, const bf16* QKVP, const float* GB, int m, int h, int col, int part) {
    const bf16* row = QKVP + (size_t)m * 1536;
#pragma unroll
    for (int i = 0; i < 4; ++i) { d.q[i] = *(const GAS v4u*)(row + h * 128 + part * 32 + 8 * i); d.k[i] = *(const GAS v4u*)(row + 512 + h * 128 + part * 32 + 8 * i); }
    d.v = bf1(row[1024 + h * 128 + col]); d.g = GB[(size_t)m * 8 + h]; d.beta = GB[(size_t)m * 8 + 4 + h];
}
__device__ __forceinline__ void unpack8(const v4u w, float* f) { f[0] = bflo(w.x); f[1] = bfhi(w.x); f[2] = bflo(w.y); f[3] = bfhi(w.y); f[4] = bflo(w.z); f[5] = bfhi(w.z); f[6] = bflo(w.w); f[7] = bfhi(w.w); }
__device__ __forceinline__ void p2b_deltanet(unsigned char* ws, int bh, int tid) {
    const bf16* QKVP = (const bf16*)(ws + WS_QKVP); const float* GB = (const float*)(ws + WS_GB); bf16* OY = (bf16*)(ws + WS_OY);
    const int b = bh >> 2, h = bh & 3, col = tid >> 2, part = tid & 3;
    float S[32];
#pragma unroll
    for (int i = 0; i < 32; ++i) S[i] = 0.f;
    DnIn cur, nxt; dn_load(cur, QKVP, GB, b * T, h, col, part);
    for (int t = 0; t < T; ++t) {
        const int m = b * T + t;
        dn_load(nxt, QKVP, GB, (t + 1 < T) ? m + 1 : m, h, col, part);
        float kf[32], qf[32];
#pragma unroll
        for (int i = 0; i < 4; ++i) { unpack8(cur.k[i], kf + 8 * i); unpack8(cur.q[i], qf + 8 * i); }
        const float a = __expf(cur.g);
        float ks = 0.f;
#pragma unroll
        for (int i = 0; i < 32; ++i) ks += kf[i] * S[i];
        ks += __shfl_xor(ks, 1); ks += __shfl_xor(ks, 2);
        const float tv = cur.beta * (cur.v - a * ks);
        float os = 0.f;
#pragma unroll
        for (int i = 0; i < 32; ++i) { S[i] = a * S[i] + kf[i] * tv; os += qf[i] * S[i]; }
        os += __shfl_xor(os, 1); os += __shfl_xor(os, 2);
        if (part == 0) OY[(size_t)m * 1024 + h * 128 + col] = (bf16)f2bf(os);
        cur = nxt;
    }
}
__device__ __forceinline__ void p2b_s5(const float* const* in, unsigned char* ws, int bg, int lane) {
    const bf16* PROJ = (const bf16*)(ws + WS_PROJ); bf16* Y0 = (bf16*)(ws + WS_Y0);
    const int b = bg >> 5, g = bg & 31, p = lane;
    float ar, ai, bbr[16], bbi[16], cr[16], ci[16];
    {
        const double dt = exp((double)in[15][g]); const double are = in[8][g * 64 + p], aim = in[9][g * 64 + p];
        const double mag = exp(are * dt), abr = mag * cos(aim * dt), abi = mag * sin(aim * dt), den = are * are + aim * aim;
        const double nr = abr - 1.0, ni = abi; const double cor = (nr * are + ni * aim) / den, coi = (ni * are - nr * aim) / den;
        ar = (float)abr; ai = (float)abi;
#pragma unroll
        for (int c = 0; c < 16; ++c) { const double br = in[10][(size_t)(g * 64 + p) * 16 + c], bi = in[11][(size_t)(g * 64 + p) * 16 + c];
            bbr[c] = (float)(cor * br - coi * bi); bbi[c] = (float)(cor * bi + coi * br);
            cr[c] = in[12][(size_t)(g * 16 + c) * 64 + p]; ci[c] = in[13][(size_t)(g * 16 + c) * 64 + p]; }
    }
    const int cme = lane >> 2; const float dme = in[14][g * 16 + cme];
    float xr = 0.f, xi = 0.f;
    const bool b5 = lane & 32, b4 = lane & 16, b3 = lane & 8, b2 = lane & 4;
    const bf16* up = PROJ + (size_t)(b * T) * NPROJ + 2048 + g * 16;
    v4u u0 = *(const GAS v4u*)up, u1 = *(const GAS v4u*)(up + 8);
    for (int t = 0; t < T; ++t) {
        const bf16* un = up + (size_t)((t + 1 < T) ? t + 1 : t) * NPROJ;
        const v4u n0 = *(const GAS v4u*)un, n1 = *(const GAS v4u*)(un + 8);
        float uf[16]; unpack8(u0, uf); unpack8(u1, uf + 8);
        float br = 0.f, bi = 0.f;
#pragma unroll
        for (int c = 0; c < 16; ++c) { br += bbr[c] * uf[c]; bi += bbi[c] * uf[c]; }
        const float nxr = ar * xr - ai * xi + br, nxi = ar * xi + ai * xr + bi; xr = nxr; xi = nxi;
        float y[16];
#pragma unroll
        for (int c = 0; c < 16; ++c) y[c] = cr[c] * xr - ci[c] * xi;
        float r8[8], r4[4], r2[2];
#pragma unroll
        for (int i = 0; i < 8; ++i) { const float keep = b5 ? y[i + 8] : y[i], send = b5 ? y[i] : y[i + 8]; r8[i] = keep + __shfl_xor(send, 32); }
#pragma unroll
        for (int i = 0; i < 4; ++i) { const float keep = b4 ? r8[i + 4] : r8[i], send = b4 ? r8[i] : r8[i + 4]; r4[i] = keep + __shfl_xor(send, 16); }
#pragma unroll
        for (int i = 0; i < 2; ++i) { const float keep = b3 ? r4[i + 2] : r4[i], send = b3 ? r4[i] : r4[i + 2]; r2[i] = keep + __shfl_xor(send, 8); }
        float r1; { const float keep = b2 ? r2[1] : r2[0], send = b2 ? r2[0] : r2[1]; r1 = keep + __shfl_xor(send, 4); }
        r1 += __shfl_xor(r1, 2); r1 += __shfl_xor(r1, 1);
        float ume = 0.f;
#pragma unroll
        for (int c = 0; c < 16; ++c) ume = (c == cme) ? uf[c] : ume;
        const float yv = r1 + dme * ume;
        const float ge = 0.5f * yv * (1.0f + tanhf(0.7978845608028654f * (yv + 0.044715f * yv * yv * yv)));
        if ((lane & 3) == 0) Y0[(size_t)(b * T + t) * 512 + g * 16 + cme] = (bf16)f2bf(ge);
        u0 = n0; u1 = n1;
    }
}
__device__ __forceinline__ void p2c_onorm(const float* const* in, unsigned char* ws, int gw, int NGW, int lane) {
    const bf16* PROJ = (const bf16*)(ws + WS_PROJ); bf16* OY = (bf16*)(ws + WS_OY); const float* ng = in[7];
    const float g0 = ng[2 * lane], g1 = ng[2 * lane + 1];
    for (int m = gw; m < M; m += NGW) {
#pragma unroll
        for (int h = 0; h < 4; ++h) {
            const unsigned ow = *(const GAS unsigned*)(OY + (size_t)m * 1024 + h * 128 + 2 * lane); const unsigned zw = *(const GAS unsigned*)(PROJ + (size_t)m * NPROJ + 1536 + h * 128 + 2 * lane);
            const float o0 = bflo(ow), o1 = bfhi(ow); const float ss = wave_sum(o0 * o0 + o1 * o1);
            const float r = 1.0f / sqrtf(ss * (1.f / 128.f) + EPS);
            *(GAS unsigned*)(OY + (size_t)m * 1024 + h * 128 + 2 * lane) = pk2(o0 * r * g0 * silu_f(bflo(zw)), o1 * r * g1 * silu_f(bfhi(zw)));
        }
    }
}
__device__ __forceinline__ void rms_rows_bf16(const float* src, const float* gain, bf16* dst, int gw, int NGW, int lane) {
    for (int m = gw; m < M; m += NGW) { f32x4 vn[4]; rms_row(src + (size_t)m * D, gain, dst + (size_t)m * D, lane, vn); }
}
__device__ __forceinline__ void rms_rows_f32_inplace(float* buf, const float* gain, int gw, int NGW, int lane) {
    for (int m = gw; m < M; m += NGW) {
        GAS f32x4* xr = (GAS f32x4*)(buf + (size_t)m * D) + lane; const GAS f32x4* gr = (const GAS f32x4*)gain + lane;
        f32x4 v[4]; float s = 0.f;
#pragma unroll
        for (int j = 0; j < 4; ++j) { v[j] = xr[64 * j]; s += (v[j].x * v[j].x + v[j].y * v[j].y) + (v[j].z * v[j].z + v[j].w * v[j].w); }
        const float r = 1.0f / sqrtf(wave_sum(s) * (1.f / 1024.f) + EPS);
#pragma unroll
        for (int j = 0; j < 4; ++j) xr[64 * j] = v[j] * r * gr[64 * j];
    }
}
__device__ __forceinline__ void p7_xattn_naive(LAS unsigned char* lds, unsigned char* ws, int gw, int NGW, int lane, int wave) {
    const bf16* QB = (const bf16*)(ws + WS_QB); const bf16* KT = (const bf16*)(ws + WS_KT); const bf16* VM = (const bf16*)(ws + WS_KV) + 1024; bf16* AO = (bf16*)(ws + WS_AO);
    LAS float* qs = (LAS float*)(lds + RING_OFF + wave * 2048); LAS float* ps = qs + 256;
    for (int it = gw; it < M * 4; it += NGW) {
        const int m = it >> 2, h = it & 3, b = m >> 12;
        { const v2u qw = *(const GAS v2u*)(QB + (size_t)m * 1024 + h * 256 + 4 * lane); *(LAS f32x4*)(qs + 4 * lane) = (f32x4){bflo(qw.x), bfhi(qw.x), bflo(qw.y), bfhi(qw.y)}; }
        LDS_WAIT(); asm volatile("" ::: "memory");
        const bf16* kt = KT + (size_t)(b * 4 + h) * 65536 + 4 * lane;
        f32x4 s = {0.f, 0.f, 0.f, 0.f};
#pragma unroll 4
        for (int d = 0; d < 256; d += 4) { const f32x4 q4 = *(const LAS f32x4*)(qs + d);
#pragma unroll
            for (int e = 0; e < 4; ++e) { const v2u kw = *(const GAS v2u*)(kt + (size_t)(d + e) * 256); const float qv = q4[e];
                s.x += qv * bflo(kw.x); s.y += qv * bfhi(kw.x); s.z += qv * bflo(kw.y); s.w += qv * bfhi(kw.y); } }
        s = s * 0.0625f;
        const float mx = wave_max(fmaxf(fmaxf(s.x, s.y), fmaxf(s.z, s.w)));
        f32x4 pz = {__expf(s.x - mx), __expf(s.y - mx), __expf(s.z - mx), __expf(s.w - mx)};
        const float inv = 1.0f / wave_sum((pz.x + pz.y) + (pz.z + pz.w));
        *(LAS f32x4*)(ps + 4 * lane) = pz * inv;
        LDS_WAIT(); asm volatile("" ::: "memory");
        const bf16* vm = VM + (size_t)b * 256 * 2048 + h * 256 + 4 * lane;
        f32x4 o = {0.f, 0.f, 0.f, 0.f};
#pragma unroll 4
        for (int k = 0; k < 256; k += 4) { const f32x4 p4 = *(const LAS f32x4*)(ps + k);
#pragma unroll
            for (int e = 0; e < 4; ++e) { const v2u vw = *(const GAS v2u*)(vm + (size_t)(k + e) * 2048); const float pv = p4[e];
                o.x += pv * bflo(vw.x); o.y += pv * bfhi(vw.x); o.z += pv * bflo(vw.y); o.w += pv * bfhi(vw.y); } }
        v2u w; w.x = pk2(o.x, o.y); w.y = pk2(o.z, o.w); *(GAS v2u*)(AO + (size_t)m * 1024 + h * 256 + 4 * lane) = w;
        LDS_WAIT(); asm volatile("" ::: "memory");
    }
}

struct Args { const float* in[30]; float* out; unsigned char* ws; int ph_lo, ph_hi, li, pad; };
__global__ void __launch_bounds__(NWAVES * 64, 2) mk_fwd(Args args) {
    extern __shared__ __attribute__((aligned(16))) unsigned char lds_raw[];
    LAS unsigned char* lds = (LAS unsigned char*)lds_raw;
    volatile LAS unsigned* MISC = (volatile LAS unsigned*)(lds + MISC_OFF);
    const int tid = threadIdx.x, lane = tid & 63, wave = __builtin_amdgcn_readfirstlane(tid >> 6);
    const int G = gridDim.x; const int bx = blockIdx.x; const int vcu = (G % 8 == 0) ? (bx % 8) * (G / 8) + bx / 8 : bx;
    unsigned char* ws = args.ws; gu32* ctl = (gu32*)(ws + WS_CTL);
    const float* const* in = args.in; float* out = args.out;
    const int gw = vcu * NWAVES + wave, NGW = G * NWAVES;
    for (int u = tid; u < (LDS_BYTES - LDSCTL_OFF) / 4; u += NWAVES * 64) ((LAS unsigned*)(lds + LDSCTL_OFF))[u] = 0u;
    __syncthreads();
    XcdBarrier bar; bar.bar = (unsigned*)(ctl + CW_BAR); bar.x = 0; bar.st = nullptr;
    if (N_LAUNCHES != PER_PHASE) bar = xcd_barrier_post((unsigned*)(ctl + CW_BAR), MISC + 8);
#define GRID_BAR(seam) do { if (N_LAUNCHES == PER_PHASE) { if (tid == 0) __hip_atomic_store(ctl + CW_TMO, 0xBADBA0u | (unsigned)(seam), RLX_AGENT); } else { xcd_barrier(bar); } } while (0)
    const int lo = args.ph_lo, hi = args.ph_hi;
#ifndef PH_MASK
#define PH_MASK 0x3fff
#endif
#define IN(k) (((PH_MASK >> (k)) & 1) && lo <= (k) && (k) < hi)
#define BOTH(k) (IN(k) && IN((k) + 1))

    if (IN(0)) { p0_prologue(lds, in, ws, gw, NGW, tid, lane, wave); if (BOTH(0)) GRID_BAR(0); }
    if (IN(1)) {
        pg8::Gemm g{(const pg8::bf16_t*)(ws + WS_XN), (const pg8::bf16_t*)(ws + WS_WIN), M + 1024, NPROJ + 2048, D}; ProjOrder S; S.init(G, bx);
        pg8::EpiProj E{(pg8::bf16_t*)(ws + WS_PROJ), (pg8::bf16_t*)(ws + WS_KV)};
        pg8::gemm_phase<pg8::EpiProj, ProjOrder, true, true>(lds + RING_OFF, g, S, E);
        if (BOTH(1)) GRID_BAR(1);
    }
    if (IN(2)) { p2a_prep(in, ws, gw, NGW, lane); if (BOTH(2)) GRID_BAR(2); }
    if (IN(3)) {
        if (vcu < 16) p2b_deltanet(ws, vcu, tid);
        else if (vcu < 32) p2b_s5(in, ws, (vcu - 16) * 8 + wave, lane);
        if (BOTH(3)) GRID_BAR(3);
    }
    if (IN(4)) {
        p2c_onorm(in, ws, gw, NGW, lane);
        pg8::Gemm g{(const pg8::bf16_t*)(ws + WS_Y0), (const pg8::bf16_t*)(ws + WS_WGLU), M, 512, 512}; pg8::StaticOrder S; S.init(M, 512, G, bx);
        pg8::EpiGlu E{(const pg8::bf16_t*)(ws + WS_Y0), in[17], (pg8::bf16_t*)(ws + WS_OY)};
        pg8::gemm_phase<pg8::EpiGlu, pg8::StaticOrder, true, true>(lds + RING_OFF, g, S, E);
        if (BOTH(4)) GRID_BAR(4);
    }
    if (IN(5)) {
        pg8::Gemm g{(const pg8::bf16_t*)(ws + WS_OY), (const pg8::bf16_t*)(ws + WS_WOUT), M, D, D}; pg8::StaticOrder S; S.init(M, D, G, bx);
        pg8::EpiResid E{in[0], out};
        pg8::gemm_phase<pg8::EpiResid, pg8::StaticOrder, true, true>(lds + RING_OFF, g, S, E);
        if (BOTH(5)) GRID_BAR(5);
    }
    if (IN(6)) { rms_rows_bf16(out, in[19], (bf16*)(ws + WS_XN), gw, NGW, lane); if (BOTH(6)) GRID_BAR(6); }
    if (IN(7)) {
        pg8::Gemm g{(const pg8::bf16_t*)(ws + WS_XN), (const pg8::bf16_t*)(ws + WS_WXQ), M, D, D}; pg8::StaticOrder S; S.init(M, D, G, bx);
        pg8::EpiBf16 E{(pg8::bf16_t*)(ws + WS_QB), D};
        pg8::gemm_phase<pg8::EpiBf16, pg8::StaticOrder, true, true>(lds + RING_OFF, g, S, E);
        if (BOTH(7)) GRID_BAR(7);
    }
    if (IN(8)) { p7_xattn_naive(lds, ws, gw, NGW, lane, wave); if (BOTH(8)) GRID_BAR(8); }
    if (IN(9)) {
        pg8::Gemm g{(const pg8::bf16_t*)(ws + WS_AO), (const pg8::bf16_t*)(ws + WS_WXO), M, D, D}; pg8::StaticOrder S; S.init(M, D, G, bx);
        pg8::EpiResid E{out, out};
        pg8::gemm_phase<pg8::EpiResid, pg8::StaticOrder, true, true>(lds + RING_OFF, g, S, E);
        if (BOTH(9)) GRID_BAR(9);
    }
    if (IN(10)) { rms_rows_bf16(out, in[25], (bf16*)(ws + WS_XN), gw, NGW, lane); if (BOTH(10)) GRID_BAR(10); }
    if (IN(11)) {
        pg8::Gemm g{(const pg8::bf16_t*)(ws + WS_XN), (const pg8::bf16_t*)(ws + WS_WGU), M, NGU, D}; pg8::StaticOrder S; S.init(M, NGU, G, bx);
        pg8::EpiSwiGlu E{(pg8::bf16_t*)(ws + WS_HID)};
        pg8::gemm_phase<pg8::EpiSwiGlu, pg8::StaticOrder, true, true>(lds + RING_OFF, g, S, E);
        if (BOTH(11)) GRID_BAR(11);
    }
    if (IN(12)) {
        pg8::Gemm g{(const pg8::bf16_t*)(ws + WS_HID), (const pg8::bf16_t*)(ws + WS_WDN), M, D, DFF}; pg8::StaticOrder S; S.init(M, D, G, bx);
        pg8::EpiResid E{out, out};
        pg8::gemm_phase<pg8::EpiResid, pg8::StaticOrder, true, true>(lds + RING_OFF, g, S, E);
        if (BOTH(12)) GRID_BAR(12);
    }
    if (IN(13)) { rms_rows_f32_inplace(out, in[29], gw, NGW, lane); }
#undef IN
#undef BOTH
}

extern "C" void kernel_launch(void* const* d_in, const int* in_sizes, int n_in, void* d_out, int out_size, void* d_ws, size_t ws_size, hipStream_t stream) {
    static int grid = 0;
    if (grid == 0) {
        if (n_in != 30 || in_sizes[0] != M * D || out_size != M * D || ws_size < WS_END) { fprintf(stderr, "kernel_launch: unexpected shapes (n_in %d, in0 %d, out %d, ws %zu); nothing launched\n", n_in, n_in > 0 ? in_sizes[0] : -1, out_size, ws_size); grid = -1; return; }
        int dev = 0, cus = 0, per_cu = 0;
        if (hipGetDevice(&dev) != hipSuccess || hipDeviceGetAttribute(&cus, hipDeviceAttributeMultiprocessorCount, dev) != hipSuccess) { grid = -1; return; }
        if (hipFuncSetAttribute((const void*)mk_fwd, hipFuncAttributeMaxDynamicSharedMemorySize, LDS_BYTES) != hipSuccess) { fprintf(stderr, "kernel_launch: hipFuncSetAttribute failed\n"); grid = -1; return; }
        if (hipOccupancyMaxActiveBlocksPerMultiprocessor(&per_cu, (const void*)mk_fwd, NWAVES * 64, LDS_BYTES) != hipSuccess || per_cu < 1) { fprintf(stderr, "kernel_launch: occupancy query reports %d workgroups per CU\n", per_cu); per_cu = 1; }
        (void)hipGetLastError();
        grid = cus;
    }
    if (grid < 0) return;
    if (hipMemsetAsync((char*)d_ws + WS_CTL, 0, CTL_ZERO_BYTES, stream) != hipSuccess) { fprintf(stderr, "kernel_launch: hipMemsetAsync failed\n"); return; }
    Args a{};
    for (int i = 0; i < 30; ++i) a.in[i] = (const float*)d_in[i];
    a.out = (float*)d_out; a.ws = (unsigned char*)d_ws;
    constexpr int NPH = 14;
    if (N_LAUNCHES == 1) { a.ph_lo = 0; a.ph_hi = NPH; a.li = 0; hipLaunchKernelGGL(mk_fwd, dim3(grid), dim3(NWAVES * 64), LDS_BYTES, stream, a); }
    else for (int li = 0; li < NPH; ++li) { a.ph_lo = li; a.ph_hi = li + 1; a.li = 0; hipLaunchKernelGGL(mk_fwd, dim3(grid), dim3(NWAVES * 64), LDS_BYTES, stream, a); }
    const hipError_t le = hipPeekAtLastError();
    if (le != hipSuccess) fprintf(stderr, "kernel_launch: launch failed: %s\n", hipGetErrorName(le));
}
```

```cpp
#include <hip/hip_runtime.h>
#include <cstdio>
#include <cstdint>
#include <cmath>
namespace pg8 {
#define PG8_LAS __attribute__((address_space(3)))
typedef unsigned short bf16_t;
typedef short bf16x8 __attribute__((ext_vector_type(8)));
typedef float f32x4 __attribute__((ext_vector_type(4)));
typedef unsigned u32x4 __attribute__((ext_vector_type(4)));
constexpr int BM = 256, BK = 64, HALF = 128, HTB = HALF * BK * 2  , STAGE_BYTES = 8 * HTB, NXCD = 8, WGM = 8;

__host__ __device__ __forceinline__ int lds_byte(int r, int c) { const int st = (r >> 4) * 2 + (c >> 5), rr = r & 15, cc = c & 31, ob = rr * 64 + cc * 2; return st * 1024 + (ob ^ (((ob >> 9) & 1) << 5)); }
__host__ __device__ __forceinline__ void stage_rc(int b, int& R, int& C) { const int st = b / 1024, sb = b % 1024, swz = sb ^ (((sb >> 9) & 1) << 5); R = (st >> 1) * 16 + swz / 64; C = (st & 1) * 32 + (swz % 64) / 2; }
__host__ __device__ __forceinline__ int perm32(int rho) { const int n = rho >> 4, i = rho & 15; return 8 * (i >> 2) + 4 * n + (i & 3); }

struct Unit { int pm, pn; };
struct Gemm { const bf16_t* A; const bf16_t* Bt; int K, lda, ldb; };

struct StaticOrder {
    int nM, nN, nwg, G, c;
    __host__ __device__ void init(int M, int N, int G_, int c_) { nM = M / BM; nN = N / BM; nwg = nM * nN; G = G_; c = c_; }
    __host__ __device__ bool next(int i, Unit& u) const {
        const long L = (long)i * G + c; if (L >= nwg) return false;
        int wgid = (int)L; { const int q = nwg / NXCD, r = nwg % NXCD, xcd = wgid % NXCD, off = wgid / NXCD; wgid = (xcd < r ? xcd * (q + 1) : r * (q + 1) + (xcd - r) * q) + off; }
        const int nig = WGM * nN, gid = wgid / nig, fm = gid * WGM, gsz = (nM - fm) < WGM ? (nM - fm) : WGM;
        u.pm = fm + ((wgid % nig) % gsz); u.pn = (wgid % nig) / gsz; return true;
    }
    __device__ __forceinline__ void a_ready(const Unit&) const {}
    __device__ __forceinline__ void done(const Unit&) const {}
};


__device__ __forceinline__ unsigned cvt_pk_bf16(float lo, float hi) { unsigned r; asm volatile("v_cvt_pk_bf16_f32 %0, %1, %2" : "=v"(r) : "v"(lo), "v"(hi)); return r; }
__device__ __forceinline__ float bf_lo(unsigned w) { return __builtin_bit_cast(float, w << 16); }
__device__ __forceinline__ float bf_hi(unsigned w) { return __builtin_bit_cast(float, w & 0xffff0000u); }
__device__ __forceinline__ u32x4 pack8(const f32x4 v0, const f32x4 v1) { u32x4 w; w.x = cvt_pk_bf16(v0[0], v0[1]); w.y = cvt_pk_bf16(v0[2], v0[3]); w.z = cvt_pk_bf16(v1[0], v1[1]); w.w = cvt_pk_bf16(v1[2], v1[3]); return w; }
__device__ __forceinline__ float sigmoid_f(float x) { return __builtin_amdgcn_rcpf(1.0f + __expf(-x)); }

struct EpiBf16 {
    static constexpr bool PERM = true, AFTER_DRAIN = false;
    bf16_t* O; int ldc;
    __device__ __forceinline__ void operator()(const f32x4 (&acc)[2][2][4][2], const Unit& u, int wr, int wc, int fr, int fq) const {
        const int row0 = u.pm * BM + wr * 64 + fr, col0 = u.pn * BM + wc * 32 + 8 * fq;
#pragma unroll
        for (int ai = 0; ai < 2; ++ai)
#pragma unroll
            for (int m = 0; m < 4; ++m) { bf16_t* rowp = O + (size_t)(row0 + ai * HALF + m * 16) * ldc + col0;
#pragma unroll
                for (int bj = 0; bj < 2; ++bj) *(u32x4*)(rowp + bj * HALF) = pack8(acc[ai][bj][m][0], acc[ai][bj][m][1]); }
    }
};
struct EpiProj {
    static constexpr bool PERM = true, AFTER_DRAIN = false;
    bf16_t* QKV; bf16_t* ZB; bf16_t* UGX; bf16_t* KV;
    __device__ __forceinline__ void operator()(const f32x4 (&acc)[2][2][4][2], const Unit& u, int wr, int wc, int fr, int fq) const {
        if (u.pn == 8 || u.pn == 9) {
            const int col0 = (u.pn - 8) * BM + wc * 32 + 8 * fq, g = col0 >> 4, ci0 = col0 & 15, b = u.pm >> 4, T0 = (u.pm & 15) * 256 + wr * 64;
            bf16_t* base = UGX + ((size_t)(g * 512 + b * 128 + (T0 >> 5)) * 640 + fr * 16 + ci0);
#pragma unroll
            for (int ai = 0; ai < 2; ++ai)
#pragma unroll
                for (int m = 0; m < 4; ++m)
#pragma unroll
                    for (int bj = 0; bj < 2; ++bj) *(u32x4*)(base + (size_t)bj * 8 * 512 * 640 + (4 * ai + (m >> 1)) * 640 + 16 * (m & 1) * 16) = pack8(acc[ai][bj][m][0], acc[ai][bj][m][1]);
        } else {
            bf16_t* O; int ldc, pm = u.pm, pn = u.pn;
            if (pn < 6) { O = QKV; ldc = 1536; } else if (pn < 8) { O = ZB; ldc = 512; pn -= 6; } else { O = KV; ldc = 2048; pn -= 10; pm -= 64; }
            const int row0 = pm * BM + wr * 64 + fr, col0 = pn * BM + wc * 32 + 8 * fq;
#pragma unroll
            for (int ai = 0; ai < 2; ++ai)
#pragma unroll
                for (int m = 0; m < 4; ++m) { bf16_t* rowp = O + (size_t)(row0 + ai * HALF + m * 16) * ldc + col0;
#pragma unroll
                    for (int bj = 0; bj < 2; ++bj) *(u32x4*)(rowp + bj * HALF) = pack8(acc[ai][bj][m][0], acc[ai][bj][m][1]); }
        }
    }
};
struct EpiXl {
    static constexpr bool PERM = false, AFTER_DRAIN = false;
    float* XL;
    __device__ __forceinline__ void operator()(const f32x4 (&acc)[2][2][4][2], const Unit& u, int wr, int wc, int fr, int fq) const {
        const int row0 = u.pm * BM + wr * 64 + fr, col0 = wc * 32 + 4 * fq;
#pragma unroll
        for (int ai = 0; ai < 2; ++ai)
#pragma unroll
            for (int m = 0; m < 4; ++m)
#pragma unroll
                for (int n = 0; n < 2; ++n) *(f32x4*)(XL + (size_t)(row0 + ai * HALF + m * 16) * 128 + col0 + n * 16) = acc[ai][0][m][n];
    }
};
struct EpiS5Out {
    static constexpr bool PERM = true, AFTER_DRAIN = false;
    const bf16_t* UGX; const float* dvec; bf16_t* Y0;
    __device__ __forceinline__ void operator()(const f32x4 (&acc)[2][2][4][2], const Unit& u, int wr, int wc, int fr, int fq) const {
        const int g = u.pm >> 1, inst0 = (u.pm & 1) * 256 + wr * 64 + fr, n0 = (u.pn & 1) * 256 + wc * 32 + 8 * fq, co0 = n0 & 15;
        const f32x4 d0 = *(const f32x4*)(dvec + g * 16 + co0), d1 = *(const f32x4*)(dvec + g * 16 + co0 + 4);
#pragma unroll
        for (int ai = 0; ai < 2; ++ai)
#pragma unroll
            for (int m = 0; m < 4; ++m) { const int inst = inst0 + ai * HALF + m * 16, b = inst >> 7, cc = inst & 127;
#pragma unroll
                for (int bj = 0; bj < 2; ++bj) { const int n = n0 + bj * HALF, t = n >> 4;
                    const u32x4 uw = *(const u32x4*)(UGX + (size_t)(g * 512 + inst) * 640 + t * 16 + co0);
                    f32x4 v0 = acc[ai][bj][m][0], v1 = acc[ai][bj][m][1];
                    v0[0] += d0[0] * bf_lo(uw.x); v0[1] += d0[1] * bf_hi(uw.x); v0[2] += d0[2] * bf_lo(uw.y); v0[3] += d0[3] * bf_hi(uw.y);
                    v1[0] += d1[0] * bf_lo(uw.z); v1[1] += d1[1] * bf_hi(uw.z); v1[2] += d1[2] * bf_lo(uw.w); v1[3] += d1[3] * bf_hi(uw.w);
#pragma unroll
                    for (int j = 0; j < 4; ++j) { float y = v0[j]; float z = 0.7978845608028654f * (y + 0.044715f * y * y * y); v0[j] = y * (1.0f - __builtin_amdgcn_rcpf(1.0f + __expf(2.0f * z)));
                        y = v1[j]; z = 0.7978845608028654f * (y + 0.044715f * y * y * y); v1[j] = y * (1.0f - __builtin_amdgcn_rcpf(1.0f + __expf(2.0f * z))); }
                    *(u32x4*)(Y0 + ((size_t)b * 4096 + cc * 32 + t) * 512 + g * 16 + co0) = pack8(v0, v1); } }
    }
};
struct EpiGlu {
    static constexpr bool PERM = true, AFTER_DRAIN = false;
    const bf16_t* Y0; const float* bglu; bf16_t* OY;
    __device__ __forceinline__ void operator()(const f32x4 (&acc)[2][2][4][2], const Unit& u, int wr, int wc, int fr, int fq) const {
        const int row0 = u.pm * BM + wr * 64 + fr, col0 = u.pn * BM + wc * 32 + 8 * fq;
#pragma unroll
        for (int bj = 0; bj < 2; ++bj) { const int col = col0 + bj * HALF; const f32x4 b0 = *(const f32x4*)(bglu + col), b1 = *(const f32x4*)(bglu + col + 4);
#pragma unroll
            for (int ai = 0; ai < 2; ++ai)
#pragma unroll
                for (int m = 0; m < 4; ++m) { const size_t r = (size_t)(row0 + ai * HALF + m * 16); const u32x4 yw = *(const u32x4*)(Y0 + r * 512 + col);
                    f32x4 v0 = acc[ai][bj][m][0] + b0, v1 = acc[ai][bj][m][1] + b1;
                    v0[0] = bf_lo(yw.x) * sigmoid_f(v0[0]); v0[1] = bf_hi(yw.x) * sigmoid_f(v0[1]); v0[2] = bf_lo(yw.y) * sigmoid_f(v0[2]); v0[3] = bf_hi(yw.y) * sigmoid_f(v0[3]);
                    v1[0] = bf_lo(yw.z) * sigmoid_f(v1[0]); v1[1] = bf_hi(yw.z) * sigmoid_f(v1[1]); v1[2] = bf_lo(yw.w) * sigmoid_f(v1[2]); v1[3] = bf_hi(yw.w) * sigmoid_f(v1[3]);
                    *(u32x4*)(OY + r * 1024 + 512 + col) = pack8(v0, v1); } }
    }
};
struct EpiResid {
    static constexpr bool PERM = false, AFTER_DRAIN = false;
    const float* base; float* out;
    __device__ __forceinline__ void operator()(const f32x4 (&acc)[2][2][4][2], const Unit& u, int wr, int wc, int fr, int fq) const {
        const int row0 = u.pm * BM + wr * 64 + fr, col0 = u.pn * BM + wc * 32 + 4 * fq;
#pragma unroll
        for (int ai = 0; ai < 2; ++ai)
#pragma unroll
            for (int m = 0; m < 4; ++m) { const size_t off = (size_t)(row0 + ai * HALF + m * 16) * 1024 + col0;
#pragma unroll
                for (int bj = 0; bj < 2; ++bj)
#pragma unroll
                    for (int n = 0; n < 2; ++n) { const f32x4 bs = *(const f32x4*)(base + off + bj * HALF + n * 16); *(f32x4*)(out + off + bj * HALF + n * 16) = bs + acc[ai][bj][m][n]; } }
    }
};
struct EpiSwiGlu {
    static constexpr bool PERM = true, AFTER_DRAIN = false;
    bf16_t* HID;
    __device__ __forceinline__ void operator()(const f32x4 (&acc)[2][2][4][2], const Unit& u, int wr, int wc, int fr, int fq) const {
        const int row0 = u.pm * BM + wr * 64 + fr, col0 = u.pn * HALF + wc * 32 + 8 * fq;
#pragma unroll
        for (int ai = 0; ai < 2; ++ai)
#pragma unroll
            for (int m = 0; m < 4; ++m) { f32x4 v[2];
#pragma unroll
                for (int n = 0; n < 2; ++n)
#pragma unroll
                    for (int j = 0; j < 4; ++j) { const float g = acc[ai][0][m][n][j]; v[n][j] = g * sigmoid_f(g) * acc[ai][1][m][n][j]; }
                *(u32x4*)(HID + (size_t)(row0 + ai * HALF + m * 16) * 2816 + col0) = pack8(v[0], v[1]); }
    }
};
template <class Epi, class Sched, bool ALIGN_EPI = false, bool SP2 = false>
__device__ __forceinline__ void gemm_phase(PG8_LAS unsigned char* lds, const Gemm g, const Sched& S, const Epi& E) {
    const int tid = threadIdx.x, wid = __builtin_amdgcn_readfirstlane(tid >> 6), lane = tid & 63, wr = wid >> 2, wc = wid & 3, fr = lane & 15, fq = lane >> 4;
    const int K = g.K, nt = K / BK, lda = g.lda, ldb = g.ldb;
    unsigned voffA[2], voffB[2];
#pragma unroll
    for (int i = 0; i < 2; ++i) { int R, C; stage_rc(tid * 16 + i * 8192, R, C); const int Rb = Epi::PERM ? ((R & ~31) + perm32(R & 31)) : R;
        voffA[i] = (unsigned)(R * lda + C) * 2u; voffB[i] = (unsigned)(Rb * ldb + C) * 2u; }
    const size_t kstep = (size_t)(BK * 2);
    const size_t hstepA = (size_t)HALF * lda * 2, hstepB = (size_t)HALF * ldb * 2;
    const size_t tstepA = 2 * hstepA, tstepB = 2 * hstepB;
    const unsigned ldsw = (unsigned)wid * 1024u;
    const int aoff = lds_byte(wr * 64 + fr, fq * 8), boff = lds_byte(wc * 32 + fr, fq * 8);
#define PG8_SA(b, h) (((b) * 2 + (h)) * HTB)
#define PG8_SB(b, h) ((4 + (b) * 2 + (h)) * HTB)
#define PG8_STAGE(bufoff, gbase, voff) do { _Pragma("unroll") for (int _i = 0; _i < 2; ++_i) \
        __builtin_amdgcn_global_load_lds((const unsigned*)((const char*)(gbase) + (voff)[_i]), (PG8_LAS unsigned*)(lds + (bufoff) + ldsw + _i * 8192), 16, 0, 0); } while (0)
#define PG8_LDA(dst, b, h) do { _Pragma("unroll") for (int m = 0; m < 4; ++m) _Pragma("unroll") for (int k = 0; k < 2; ++k) dst[m][k] = *(const PG8_LAS bf16x8*)(lds + PG8_SA(b, h) + aoff + m * 2048 + k * 1024); } while (0)
#define PG8_LDB(dst, b, h) do { _Pragma("unroll") for (int n = 0; n < 2; ++n) _Pragma("unroll") for (int k = 0; k < 2; ++k) dst[n][k] = *(const PG8_LAS bf16x8*)(lds + PG8_SB(b, h) + boff + n * 2048 + k * 1024); } while (0)
#define PG8_MMA(ai, bj, At, Bt) do { __builtin_amdgcn_s_setprio(1); _Pragma("unroll") for (int m = 0; m < 4; ++m) _Pragma("unroll") for (int n = 0; n < 2; ++n) _Pragma("unroll") for (int k = 0; k < 2; ++k) \
        acc[ai][bj][m][n] = __builtin_amdgcn_mfma_f32_16x16x32_bf16(Bt[n][k], At[m][k], acc[ai][bj][m][n], 0, 0, 0); __builtin_amdgcn_s_setprio(0); } while (0)
#define PG8_WAIT_V(n) asm volatile("s_waitcnt vmcnt(" #n ")" ::: "memory")
#define PG8_WAIT_L(n) asm volatile("s_waitcnt lgkmcnt(" #n ")" ::: "memory")
#define PG8_BAR __builtin_amdgcn_s_barrier()
#define PG8_SCHED __builtin_amdgcn_sched_barrier(0)
    Unit cur, nxt; int ui = 0;
    if (!S.next(0, cur)) return;
    f32x4 acc[2][2][4][2];
#pragma unroll
    for (int a = 0; a < 2; ++a)
#pragma unroll
        for (int b = 0; b < 2; ++b)
#pragma unroll
            for (int m = 0; m < 4; ++m)
#pragma unroll
                for (int n = 0; n < 2; ++n) acc[a][b][m][n] = (f32x4){0.f, 0.f, 0.f, 0.f};
    bf16x8 At[4][2], B0[2][2], B1[2][2];
    const char* cA = (const char*)g.A + (size_t)cur.pm * tstepA; const char* cB = (const char*)g.Bt + (size_t)cur.pn * tstepB;
    S.a_ready(cur);
    if constexpr (SP2) {
        PG8_STAGE(PG8_SB(0, 0), cB, voffB); PG8_STAGE(PG8_SB(0, 1), cB + hstepB, voffB); PG8_STAGE(PG8_SA(0, 0), cA, voffA); PG8_STAGE(PG8_SA(0, 1), cA + hstepA, voffA);
        if (wr == 1) PG8_BAR;
        PG8_WAIT_V(2); PG8_BAR;
        PG8_STAGE(PG8_SB(1, 0), cB + kstep, voffB); PG8_STAGE(PG8_SA(1, 0), cA + kstep, voffA); PG8_STAGE(PG8_SB(1, 1), cB + hstepB + kstep, voffB);
        PG8_WAIT_V(6); PG8_BAR;
    } else {
        PG8_STAGE(PG8_SB(0, 0), cB, voffB); PG8_STAGE(PG8_SA(0, 0), cA, voffA); PG8_STAGE(PG8_SB(0, 1), cB + hstepB, voffB); PG8_STAGE(PG8_SA(0, 1), cA + hstepA, voffA);
        if (wr == 1) PG8_BAR;
        PG8_WAIT_V(4); PG8_BAR;
        PG8_STAGE(PG8_SB(1, 0), cB + kstep, voffB); PG8_STAGE(PG8_SA(1, 0), cA + kstep, voffA); PG8_STAGE(PG8_SB(1, 1), cB + hstepB + kstep, voffB);
        PG8_WAIT_V(6); PG8_BAR;
    }
    for (;;) {
        const bool has_next = S.next(ui + 1, nxt);
        const char* nA = has_next ? (const char*)g.A + (size_t)nxt.pm * tstepA : cA; const char* nB = has_next ? (const char*)g.Bt + (size_t)nxt.pn * tstepB : cB;
        for (int t = 0; t < nt; t += 2) {
            const bool last = (t == nt - 2);
            const char* a1 = cA + (size_t)(t + 1) * kstep;
            const char* a2 = last ? nA : cA + (size_t)(t + 2) * kstep; const char* b2 = last ? nB : cB + (size_t)(t + 2) * kstep;
            const char* a3 = a2 + kstep; const char* b3 = b2 + kstep;
            if (last && has_next) S.a_ready(nxt);
            if constexpr (SP2) {
            PG8_LDB(B0, 0, 0); PG8_LDB(B1, 0, 1); PG8_SCHED; PG8_LDA(At, 0, 0); PG8_STAGE(PG8_SA(1, 1), a1 + hstepA, voffA);
            PG8_WAIT_V(8); PG8_WAIT_L(0); PG8_BAR; PG8_MMA(0, 0, At, B0); PG8_MMA(0, 1, At, B1); PG8_BAR; PG8_SCHED;
            PG8_LDA(At, 0, 1); PG8_STAGE(PG8_SB(0, 0), b2, voffB); PG8_STAGE(PG8_SB(0, 1), b2 + hstepB, voffB); PG8_STAGE(PG8_SA(0, 0), a2, voffA);
            PG8_WAIT_V(8); PG8_WAIT_L(0); PG8_BAR; PG8_MMA(1, 0, At, B0); PG8_MMA(1, 1, At, B1); PG8_BAR; PG8_SCHED;
            PG8_LDB(B0, 1, 0); PG8_LDB(B1, 1, 1); PG8_SCHED; PG8_LDA(At, 1, 0); PG8_STAGE(PG8_SA(0, 1), a2 + hstepA, voffA);
            PG8_WAIT_V(8); PG8_WAIT_L(0); PG8_BAR; PG8_MMA(0, 0, At, B0); PG8_MMA(0, 1, At, B1); PG8_BAR; PG8_SCHED;
            PG8_LDA(At, 1, 1); PG8_STAGE(PG8_SB(1, 0), b3, voffB); PG8_STAGE(PG8_SB(1, 1), b3 + hstepB, voffB); PG8_STAGE(PG8_SA(1, 0), a3, voffA);
            PG8_WAIT_V(8); PG8_WAIT_L(0); PG8_BAR; PG8_MMA(1, 0, At, B0); PG8_MMA(1, 1, At, B1); PG8_BAR; PG8_SCHED;
            } else {
            PG8_LDB(B0, 0, 0); PG8_SCHED; PG8_LDA(At, 0, 0); PG8_STAGE(PG8_SA(1, 1), a1 + hstepA, voffA);
            PG8_WAIT_L(8); PG8_BAR; PG8_WAIT_L(0); PG8_MMA(0, 0, At, B0); PG8_BAR; PG8_SCHED;
            PG8_LDB(B1, 0, 1); PG8_STAGE(PG8_SB(0, 0), b2, voffB);
            PG8_BAR; PG8_WAIT_L(0); PG8_MMA(0, 1, At, B1); PG8_BAR;
            PG8_LDA(At, 0, 1); PG8_STAGE(PG8_SA(0, 0), a2, voffA);
            PG8_BAR; PG8_WAIT_L(0); PG8_MMA(1, 0, At, B0); PG8_BAR; PG8_SCHED;
            PG8_STAGE(PG8_SB(0, 1), b2 + hstepB, voffB);
            PG8_WAIT_V(6); PG8_BAR; PG8_MMA(1, 1, At, B1); PG8_BAR;
            PG8_LDB(B0, 1, 0); PG8_SCHED; PG8_LDA(At, 1, 0); PG8_STAGE(PG8_SA(0, 1), a2 + hstepA, voffA);
            PG8_WAIT_L(8); PG8_BAR; PG8_WAIT_L(0); PG8_MMA(0, 0, At, B0); PG8_BAR; PG8_SCHED;
            PG8_LDB(B1, 1, 1); PG8_STAGE(PG8_SB(1, 0), b3, voffB);
            PG8_BAR; PG8_WAIT_L(0); PG8_MMA(0, 1, At, B1); PG8_BAR;
            PG8_LDA(At, 1, 1); PG8_STAGE(PG8_SA(1, 0), a3, voffA);
            PG8_BAR; PG8_WAIT_L(0); PG8_MMA(1, 0, At, B0); PG8_BAR; PG8_SCHED;
            PG8_STAGE(PG8_SB(1, 1), b3 + hstepB, voffB);
            PG8_WAIT_V(6); PG8_BAR; PG8_MMA(1, 1, At, B1); PG8_BAR;
            }
        }
        if constexpr (ALIGN_EPI) { if (wr == 0) PG8_BAR; }
        if constexpr (!Epi::AFTER_DRAIN) { E(acc, cur, wr, wc, fr, fq); S.done(cur); }
        if (!has_next) break;
#pragma unroll
        for (int a = 0; a < 2; ++a)
#pragma unroll
            for (int b = 0; b < 2; ++b)
#pragma unroll
                for (int m = 0; m < 4; ++m)
#pragma unroll
                    for (int n = 0; n < 2; ++n) acc[a][b][m][n] = (f32x4){0.f, 0.f, 0.f, 0.f};
        cur = nxt; cA = nA; cB = nB; ++ui;
        if constexpr (ALIGN_EPI) { if (wr == 1) PG8_BAR; }
    }
    PG8_WAIT_V(0);
    if constexpr (!ALIGN_EPI) { if (wr == 0) PG8_BAR; }
    PG8_BAR;
    if constexpr (Epi::AFTER_DRAIN) { E.fused(acc, cur, wr, wc, fr, fq, lds, wid, lane); S.done(cur); }
#undef PG8_SA
#undef PG8_SB
#undef PG8_STAGE
#undef PG8_LDA
#undef PG8_LDB
#undef PG8_MMA
#undef PG8_WAIT_V
#undef PG8_WAIT_L
#undef PG8_BAR
#undef PG8_SCHED
}
}

constexpr int NWAVES = 8;
#ifndef MK_N_LAUNCHES
#define MK_N_LAUNCHES 1
#endif
constexpr int PER_PHASE = 15;
constexpr int N_LAUNCHES = MK_N_LAUNCHES;

constexpr int BATCH = 4, T = 4096, D = 1024, M = BATCH * T, NMEM = 256;
constexpr int DIN = 2568, NPROJ = 2560, DFF = 2816, NGU = 2 * DFF;
constexpr float EPS = 1e-6f;

constexpr size_t MiB = 1u << 20;
constexpr size_t WS_CTL = 0, CTL_ZERO_BYTES = 65536;
constexpr size_t WS_KT5 = 65536;
constexpr size_t WS_A32 = 65536 + 512 * 1024;
constexpr size_t WS_WIN = 1 * MiB;
constexpr size_t WS_WKV = 6 * MiB;
constexpr size_t WS_XL = 1 * MiB;
constexpr size_t WS_WGLU = 10 * MiB;
constexpr size_t WS_WOUT = 10 * MiB + 512 * 1024;
constexpr size_t WS_WXQ = WS_WOUT + 2 * MiB, WS_WXO = WS_WXQ + 2 * MiB;
constexpr size_t WS_WGU = WS_WXO + 2 * MiB;
constexpr size_t WS_WDN = WS_WGU + 11 * MiB;
constexpr size_t WS_XN = 33 * MiB;
constexpr size_t WS_MN = 65 * MiB;
constexpr size_t WS_UT = 33 * MiB;
constexpr size_t WS_Y0 = 49 * MiB;
constexpr size_t WS_QKV = 67 * MiB;
constexpr size_t WS_TZC = 67 * MiB;
constexpr size_t WS_ZB = 115 * MiB;
constexpr size_t WS_UGX = 131 * MiB;
constexpr size_t WS_KT = 151 * MiB, WS_VT = 153 * MiB;
constexpr size_t WS_AB = 155 * MiB;
constexpr size_t WS_AL = 155 * MiB + 768 * 1024;
constexpr size_t WS_OY = 156 * MiB;
constexpr size_t WS_DNA = 188 * MiB;
constexpr size_t WS_KV = 244 * MiB;
constexpr size_t WS_MA = 248 * MiB;
constexpr size_t WS_QB = 67 * MiB, WS_AO = 99 * MiB;
constexpr size_t WS_HID = 67 * MiB;
constexpr size_t WS_END = 256 * MiB;
static_assert(WS_WDN + (size_t)D * DFF * 2 <= WS_XN && WS_DNA + (size_t)1024 * 57344 <= WS_KV && WS_HID + (size_t)M * DFF * 2 <= WS_OY + 32 * MiB && WS_MA + 8 * MiB <= WS_END, "d_ws map");
constexpr int CW_TMO = 0, CW_CODE = 1;
constexpr int CW_BAR = 4096;

constexpr int RING_OFF = 0, RING_BYTES = 131072;
constexpr int LDSCTL_OFF = RING_BYTES, MISC_OFF = LDSCTL_OFF + 320;
constexpr int LDS_BYTES = 147456;
static_assert(MISC_OFF + 128 <= LDS_BYTES, "LDS map");
#define GAS __attribute__((address_space(1)))
#define LAS __attribute__((address_space(3)))
typedef unsigned short bf16;
typedef unsigned v4u __attribute__((ext_vector_type(4)));
typedef float f32x4 __attribute__((ext_vector_type(4)));
typedef short bf16x8 __attribute__((ext_vector_type(8)));
typedef GAS unsigned gu32;
typedef GAS unsigned long long gu64;
#define RLX_AGENT __ATOMIC_RELAXED, __HIP_MEMORY_SCOPE_AGENT
#define LDS_WAIT() asm volatile("s_waitcnt lgkmcnt(0)" ::: "memory")
#define VM_WAIT() asm volatile("s_waitcnt vmcnt(0)" ::: "memory")
__device__ __forceinline__ unsigned long long rt() { return __builtin_amdgcn_s_memrealtime(); }
__device__ __forceinline__ unsigned f2bf(float f) { unsigned u = __builtin_bit_cast(unsigned, f); return (u + 0x7fffu + ((u >> 16) & 1u)) >> 16; }
__device__ __forceinline__ unsigned pk2(float lo, float hi) { return f2bf(lo) | (f2bf(hi) << 16); }

#define XB_TMO      128
#define XB_XCNT(j)  (256  + 64 * (j))
#define XB_XSUB(j)  (1280 + 64 * (j))
#define XB_XGEN(j)  (2304 + 64 * (j))
#define XB_TOP      3328
#define XB_TOPGEN   3392
#define XCD_BAR_WORDS 3456
#define XB_SPIN_CAP (1u << 18)

__device__ __forceinline__ unsigned xb_ld(unsigned* p)              { return __hip_atomic_load(p, __ATOMIC_RELAXED, __HIP_MEMORY_SCOPE_AGENT); }
__device__ __forceinline__ unsigned xb_add(unsigned* p, unsigned v) { return __hip_atomic_fetch_add(p, v, __ATOMIC_RELAXED, __HIP_MEMORY_SCOPE_AGENT); }
__device__ __forceinline__ unsigned xb_xcc_id() { return (unsigned)__builtin_amdgcn_s_getreg((3 << 11) | 20) & 0xFu; }
#define XB_SPIN(cond, bar) do { unsigned _sp = 0; while (cond) { __builtin_amdgcn_s_sleep(1); \
    if ((++_sp & 255u) == 0u) { if (xb_ld(&(bar)[XB_TMO])) break; if (_sp > XB_SPIN_CAP) { atomicAdd(&(bar)[XB_TMO], 1u); break; } } } } while (0)

struct XcdBarrier {
    unsigned* bar; unsigned x;
    volatile LAS unsigned* st;
};

__device__ __forceinline__ XcdBarrier xcd_barrier_post(unsigned* bar, volatile LAS unsigned* st) {
    XcdBarrier b; b.bar = bar; b.x = xb_xcc_id(); b.st = st;
    if (threadIdx.x == 0) (void)xb_add(&bar[XB_XCNT(b.x)], 1u);
    return b;
}
__device__ __forceinline__ void xcd_barrier_complete(unsigned* bar, unsigned x, unsigned& nloc, unsigned& nx) {
    const unsigned G = gridDim.x * gridDim.y * gridDim.z;
    unsigned sum, cnt, mine, sp = 0u;
    for (;;) {
        sum = 0u; cnt = 0u; mine = 0u;
#pragma unroll
        for (unsigned j = 0; j < 16; ++j) { const unsigned c = xb_ld(&bar[XB_XCNT(j)]); sum += c; cnt += (c > 0u) ? 1u : 0u; mine = (j == x) ? c : mine; }
        if (sum == G) break;
        __builtin_amdgcn_s_sleep(1);
        if ((++sp & 255u) == 0u) { if (xb_ld(&bar[XB_TMO])) break; if (sp > XB_SPIN_CAP) { atomicAdd(&bar[XB_TMO], 1u); break; } }
    }
    nloc = mine > 0u ? mine : 1u; nx = cnt > 0u ? cnt : 1u;
}

__device__ __forceinline__ void xcd_barrier(const XcdBarrier& b) {
    asm volatile("s_waitcnt vmcnt(0)" ::: "memory");
    __syncthreads();
    if (threadIdx.x == 0) {
        unsigned* bar = b.bar;
        __builtin_amdgcn_s_waitcnt(0);
        unsigned nloc = b.st[0], nx = b.st[1];
        if (nloc == 0u) { xcd_barrier_complete(bar, b.x, nloc, nx); b.st[0] = nloc; b.st[1] = nx; }
        const unsigned old = xb_add(&bar[XB_XSUB(b.x)], 1u);
        const unsigned gen = old / nloc;
        if (old + 1u == (gen + 1u) * nloc) {
            __builtin_amdgcn_fence(__ATOMIC_RELEASE, "agent");
            asm volatile("s_waitcnt vmcnt(0)" ::: "memory");
            const unsigned og = xb_add(&bar[XB_TOP], 1u);
            const unsigned tg = og / nx;
            if (og + 1u == (tg + 1u) * nx) xb_add(&bar[XB_TOPGEN], 1u);
            else XB_SPIN(xb_ld(&bar[XB_TOPGEN]) == tg, bar);
            __builtin_amdgcn_fence(__ATOMIC_ACQUIRE, "agent");
            xb_add(&bar[XB_XGEN(b.x)], 1u);
            asm volatile("s_waitcnt vmcnt(0)" ::: "memory");
        } else {
            XB_SPIN(xb_ld(&bar[XB_XGEN(b.x)]) == gen, bar);
            __builtin_amdgcn_fence(__ATOMIC_ACQUIRE, "agent");
            asm volatile("s_waitcnt vmcnt(0)" ::: "memory");
        }
    }
    __syncthreads();
}

typedef unsigned v2u __attribute__((ext_vector_type(2)));
typedef float f32x2g __attribute__((ext_vector_type(2)));
__device__ __forceinline__ float wave_sum(float v) {
#pragma unroll
    for (int o = 1; o < 64; o <<= 1) v += __shfl_xor(v, o);
    return v;
}
__device__ __forceinline__ float wave_max(float v) {
#pragma unroll
    for (int o = 1; o < 64; o <<= 1) v = fmaxf(v, __shfl_xor(v, o));
    return v;
}
__device__ __forceinline__ float bflo(unsigned w) { return __builtin_bit_cast(float, w << 16); }
__device__ __forceinline__ float bfhi(unsigned w) { return __builtin_bit_cast(float, w & 0xffff0000u); }
__device__ __forceinline__ float bf1(bf16 h) { return __builtin_bit_cast(float, (unsigned)h << 16); }
__device__ __forceinline__ float silu_f(float x) { return x / (1.0f + __expf(-x)); }
__device__ __forceinline__ void unpack8(const v4u w, float* f) { f[0] = bflo(w.x); f[1] = bfhi(w.x); f[2] = bflo(w.y); f[3] = bfhi(w.y); f[4] = bflo(w.z); f[5] = bfhi(w.z); f[6] = bflo(w.w); f[7] = bfhi(w.w); }

__device__ __forceinline__ void transpose_item(const float* W, int ldw, int k0, int c0, bf16* WT, int Kd, int r0, LAS float* scr, int lane) {
#pragma unroll 8
    for (int i = 0; i < 32; ++i) { const int kk = 2 * i + (lane >> 5); scr[kk * 33 + (lane & 31)] = W[(size_t)(k0 + kk) * ldw + c0 + (lane & 31)]; }
    LDS_WAIT(); asm volatile("" ::: "memory");
    const int c = lane & 7;
#pragma unroll
    for (int j = 0; j < 4; ++j) { const int n = (lane >> 3) + 8 * j; const LAS float* s = scr + (8 * c) * 33 + n;
        v4u o; o.x = pk2(s[0 * 33], s[1 * 33]); o.y = pk2(s[2 * 33], s[3 * 33]); o.z = pk2(s[4 * 33], s[5 * 33]); o.w = pk2(s[6 * 33], s[7 * 33]);
        *(GAS v4u*)(WT + (size_t)(r0 + n) * Kd + k0 + 8 * c) = o; }
    LDS_WAIT(); asm volatile("" ::: "memory");
}
__device__ __forceinline__ void rms_row(const float* xrow, const float* gain, bf16* orow, int lane, f32x4 (&vn)[4]) {
    const GAS f32x4* xr = (const GAS f32x4*)xrow + lane; const GAS f32x4* gr = (const GAS f32x4*)gain + lane;
    float s = 0.f;
#pragma unroll
    for (int j = 0; j < 4; ++j) { vn[j] = xr[64 * j]; s += (vn[j].x * vn[j].x + vn[j].y * vn[j].y) + (vn[j].z * vn[j].z + vn[j].w * vn[j].w); }
    const float r = 1.0f / sqrtf(wave_sum(s) * (1.f / 1024.f) + EPS);
    GAS v2u* o8 = (GAS v2u*)orow + lane;
#pragma unroll
    for (int j = 0; j < 4; ++j) { const f32x4 g = gr[64 * j]; vn[j] = vn[j] * r * g; v2u w; w.x = pk2(vn[j].x, vn[j].y); w.y = pk2(vn[j].z, vn[j].w); o8[64 * j] = w; }
}

__device__ __forceinline__ void s5_tables(LAS unsigned char* lds, const float* const* in, unsigned char* ws, int g, int tid) {
    LAS float* PWR = (LAS float*)lds;
    LAS float* PWI = PWR + 33 * 64;
    LAS float* BBR = PWI + 33 * 64;
    LAS float* BBI = BBR + 1024;
    LAS float* CCR = BBI + 1024;
    LAS float* CCI = CCR + 1024;
    if (tid < 64) {
        const int p = tid;
        const double dt = exp((double)in[15][g]); const double are = in[8][g * 64 + p], aim = in[9][g * 64 + p];
        const double mag = exp(are * dt), abr = mag * cos(aim * dt), abi = mag * sin(aim * dt), den = are * are + aim * aim;
        const double nr = abr - 1.0, ni = abi; const double cor = (nr * are + ni * aim) / den, coi = (ni * are - nr * aim) / den;
        double pr = 1.0, pi = 0.0;
        for (int t = 0; t <= 32; ++t) { PWR[t * 64 + p] = (float)pr; PWI[t * 64 + p] = (float)pi; const double nr2 = pr * abr - pi * abi, ni2 = pr * abi + pi * abr; pr = nr2; pi = ni2; }
        float* a32 = (float*)(ws + WS_A32) + (g * 64 + p) * 2; a32[0] = PWR[32 * 64 + p]; a32[1] = PWI[32 * 64 + p];
        for (int c = 0; c < 16; ++c) { const double br = in[10][(size_t)(g * 64 + p) * 16 + c], bi = in[11][(size_t)(g * 64 + p) * 16 + c];
            BBR[p * 16 + c] = (float)(cor * br - coi * bi); BBI[p * 16 + c] = (float)(cor * bi + coi * br);
            CCR[c * 64 + p] = in[12][(size_t)(g * 16 + c) * 64 + p]; CCI[c * 64 + p] = in[13][(size_t)(g * 16 + c) * 64 + p]; }
    }
    __syncthreads();
    {
        const int co = (tid & 255) >> 4, ci = tid & 15, t0 = (tid >> 8) * 16;
        float acc[16];
#pragma unroll
        for (int t = 0; t < 16; ++t) acc[t] = 0.f;
        for (int p = 0; p < 64; ++p) { const float cr = CCR[co * 64 + p], cim = CCI[co * 64 + p], br = BBR[p * 16 + ci], bi = BBI[p * 16 + ci];
            const float xr = cr * br - cim * bi, xi = cr * bi + cim * br;
#pragma unroll
            for (int t = 0; t < 16; ++t) acc[t] += xr * PWR[(t0 + t) * 64 + p] - xi * PWI[(t0 + t) * 64 + p]; }
        bf16* kt5 = (bf16*)(ws + WS_KT5) + (size_t)g * 32 * 256;
#pragma unroll
        for (int t = 0; t < 16; ++t) kt5[(t0 + t) * 256 + co * 16 + ci] = (bf16)f2bf(acc[t]);
    }
    bf16* ma = (bf16*)(ws + WS_MA) + (size_t)g * 256 * 512;
    {
        unsigned* mc = (unsigned*)(ma + 128 * 512);
        for (int idx = tid; idx < 512 * 64; idx += 512) { const int p = idx & 63, n = idx >> 6, t = n >> 4, co = n & 15;
            const float cr = CCR[co * 64 + p], cim = CCI[co * 64 + p], ar = PWR[(t + 1) * 64 + p], ai = PWI[(t + 1) * 64 + p];
            mc[idx] = pk2(cr * ar - cim * ai, -(cr * ai + cim * ar)); }
    }
    {
        for (int idx = tid; idx < 128 * 128; idx += 512) { const int k4 = idx & 127, n = idx >> 7, p = n >> 1, ri = n & 1, s = k4 >> 2, ci = (k4 & 3) * 4;
            const float ar = PWR[(31 - s) * 64 + p], ai = PWI[(31 - s) * 64 + p]; float v[4];
#pragma unroll
            for (int e = 0; e < 4; ++e) { const float br = BBR[p * 16 + ci + e], bi = BBI[p * 16 + ci + e]; v[e] = ri ? (ar * bi + ai * br) : (ar * br - ai * bi); }
            v2u o; o.x = pk2(v[0], v[1]); o.y = pk2(v[2], v[3]); *(GAS v2u*)(ma + (size_t)n * 512 + k4 * 4) = o; }
    }
    __syncthreads();
}
__device__ __forceinline__ void s5_scan(unsigned char* ws, int id) {
    const int p = id & 63, b = (id >> 6) & 3, g = id >> 8;
    const float* a32 = (const float*)(ws + WS_A32) + (g * 64 + p) * 2; const float ar = a32[0], ai = a32[1];
    const float* xl = (const float*)(ws + WS_XL) + (size_t)(g * 512 + b * 128) * 128 + 2 * p;
    unsigned* xp = (unsigned*)((bf16*)(ws + WS_UGX) + (size_t)(g * 512 + b * 128) * 640 + 512 + 2 * p);
    float xr = 0.f, xi = 0.f;
    for (int c0 = 0; c0 < 128; c0 += 8) {
        float lr[8], li[8];
#pragma unroll
        for (int e = 0; e < 8; ++e) { const f32x2g v = *(const GAS f32x2g*)(xl + (size_t)(c0 + e) * 128); lr[e] = v.x; li[e] = v.y; }
#pragma unroll
        for (int e = 0; e < 8; ++e) { xp[(size_t)(c0 + e) * 320] = pk2(xr, xi); const float nr = ar * xr - ai * xi + lr[e], ni = ar * xi + ai * xr + li[e]; xr = nr; xi = ni; }
    }
}
__device__ __forceinline__ void s5_expand(unsigned char* ws, int w0, int nw, int lane) {
    const bf16* kt5 = (const bf16*)(ws + WS_KT5); const bf16* ma = (const bf16*)(ws + WS_MA); bf16* tzc = (bf16*)(ws + WS_TZC);
    for (int row = w0; row < 32 * 512; row += nw) {
        const int g = row >> 9, n = row & 511, t = n >> 4, co = n & 15, s = lane >> 1, hf = lane & 1;
        v4u v = (v4u){0u, 0u, 0u, 0u};
        if (s <= t) v = *(const GAS v4u*)(kt5 + ((size_t)(g * 32 + (t - s)) * 16 + co) * 16 + hf * 8);
        bf16* dst = tzc + (size_t)row * 640;
        *(GAS v4u*)(dst + lane * 8) = v;
        if (lane < 16) *(GAS v4u*)(dst + 512 + lane * 8) = *(const GAS v4u*)(ma + (size_t)g * 256 * 512 + 128 * 512 + (size_t)n * 128 + lane * 8);
    }
}

__device__ __forceinline__ void p0_prologue(LAS unsigned char* lds, const float* const* in, unsigned char* ws, int vcu, int gw, int NGW, int tid, int lane, int wave) {
    LAS float* scr = (LAS float*)(lds + RING_OFF + wave * 8704);
    LAS float* wab = (LAS float*)(lds + RING_OFF + 8 * 8704);
    const float* w_in = in[3];
    if (vcu < 32) s5_tables(lds, in, ws, vcu, tid);
    for (int idx = tid; idx < 8192; idx += NWAVES * 64) { const int c = idx & 7, k = idx >> 3; wab[c * 1024 + k] = w_in[(size_t)k * DIN + 2048 + c]; }
    constexpr int I_IN = 16 * 80, I_SQ = 16 * 32, I_GLU = 8 * 16, I_G = 16 * 88, I_DN = 44 * 32;
    constexpr int NITEMS = I_IN + 2 * I_SQ + I_GLU + 3 * I_SQ + 2 * I_G + I_DN;
    for (int it = gw; it < NITEMS; it += NGW) {
        int r = it;
        if (r < I_IN) { const int kb = r / 80, nb = r % 80; transpose_item(w_in, DIN, 64 * kb, 32 * nb + (nb >= 64 ? 8 : 0), (bf16*)(ws + WS_WIN), 1024, 32 * nb, scr, lane); continue; } r -= I_IN;
        if (r < I_SQ) { const int kb = r / 32, nb = r % 32; transpose_item(in[22], 1024, 64 * kb, 32 * nb, (bf16*)(ws + WS_WKV), 1024, 32 * nb, scr, lane); continue; } r -= I_SQ;
        if (r < I_SQ) { const int kb = r / 32, nb = r % 32; transpose_item(in[23], 1024, 64 * kb, 32 * nb, (bf16*)(ws + WS_WKV), 1024, 1024 + 32 * nb, scr, lane); continue; } r -= I_SQ;
        if (r < I_GLU) { const int kb = r / 16, nb = r % 16; transpose_item(in[16], 512, 64 * kb, 32 * nb, (bf16*)(ws + WS_WGLU), 512, 32 * nb, scr, lane); continue; } r -= I_GLU;
        if (r < I_SQ) { const int kb = r / 32, nb = r % 32; transpose_item(in[18], 1024, 64 * kb, 32 * nb, (bf16*)(ws + WS_WOUT), 1024, 32 * nb, scr, lane); continue; } r -= I_SQ;
        if (r < I_SQ) { const int kb = r / 32, nb = r % 32; transpose_item(in[21], 1024, 64 * kb, 32 * nb, (bf16*)(ws + WS_WXQ), 1024, 32 * nb, scr, lane); continue; } r -= I_SQ;
        if (r < I_SQ) { const int kb = r / 32, nb = r % 32; transpose_item(in[24], 1024, 64 * kb, 32 * nb, (bf16*)(ws + WS_WXO), 1024, 32 * nb, scr, lane); continue; } r -= I_SQ;
        if (r < I_G) { const int kb = r / 88, nb = r % 88; transpose_item(in[26], DFF, 64 * kb, 32 * nb, (bf16*)(ws + WS_WGU), 1024, 256 * (nb >> 2) + 32 * (nb & 3), scr, lane); continue; } r -= I_G;
        if (r < I_G) { const int kb = r / 88, nb = r % 88; transpose_item(in[27], DFF, 64 * kb, 32 * nb, (bf16*)(ws + WS_WGU), 1024, 256 * (nb >> 2) + 128 + 32 * (nb & 3), scr, lane); continue; } r -= I_G;
        { const int kb = r / 32, nb = r % 32; transpose_item(in[28], 1024, 64 * kb, 32 * nb, (bf16*)(ws + WS_WDN), DFF, 32 * nb, scr, lane); }
    }
    __syncthreads();
    float* AB = (float*)(ws + WS_AB);
    for (int m = gw; m < M + BATCH * NMEM; m += NGW) {
        f32x4 vn[4];
        if (m < M) {
            rms_row(in[0] + (size_t)m * D, in[2], (bf16*)(ws + WS_XN) + (size_t)m * D, lane, vn);
#pragma unroll
            for (int c = 0; c < 8; ++c) { float p = 0.f;
#pragma unroll
                for (int j = 0; j < 4; ++j) { const f32x4 w = *(const LAS f32x4*)(wab + c * 1024 + 4 * lane + 256 * j); p += (vn[j].x * w.x + vn[j].y * w.y) + (vn[j].z * w.z + vn[j].w * w.w); }
                p = wave_sum(p); if (lane == 0) AB[(size_t)m * 8 + c] = p; }
        } else rms_row(in[1] + (size_t)(m - M) * D, in[20], (bf16*)(ws + WS_MN) + (size_t)(m - M) * D, lane, vn);
    }
}

struct ProjOrder {
    pg8::StaticOrder so; int G, c;
    __device__ void init(int G_, int c_) { so.init(M, NPROJ, G_, c_); G = G_; c = c_; }
    __device__ bool next(int i, pg8::Unit& u) const {
        long L = (long)i * G + c; if (L < 640) return so.next(i, u);
        L -= 640; if (L >= 32) return false; u.pm = 64 + (int)(L & 3); u.pn = 10 + (int)(L >> 2); return true;
    }
    __device__ __forceinline__ void a_ready(const pg8::Unit&) const {}
    __device__ __forceinline__ void done(const pg8::Unit&) const {}
};

struct S5aOrder { int G, c;
    __device__ bool next(int i, pg8::Unit& u) const { const long L = (long)i * G + c; if (L >= 64) return false; u.pm = (int)L; u.pn = (int)(L >> 1); return true; }
    __device__ __forceinline__ void a_ready(const pg8::Unit&) const {}
    __device__ __forceinline__ void done(const pg8::Unit&) const {}
};
struct S5cOrder { int G, c;
    __device__ bool next(int i, pg8::Unit& u) const { const long L = (long)i * G + c; if (L >= 128) return false; const int g = (int)(L >> 2); u.pm = 2 * g + (int)((L >> 1) & 1); u.pn = 2 * g + (int)(L & 1); return true; }
    __device__ __forceinline__ void a_ready(const pg8::Unit&) const {}
    __device__ __forceinline__ void done(const pg8::Unit&) const {}
};
__device__ __forceinline__ void p2a_prep(unsigned char* ws, int gw, int NGW, int lane) {
    const bf16* KV = (const bf16*)(ws + WS_KV);
    for (int cw = gw; cw < 2 * 16 * 32 * 4; cw += NGW) {
        const int d = (cw & 3) * 64 + lane, kb = (cw >> 2) & 31, bh = (cw >> 7) & 15, which = cw >> 11;
        const bf16* src = KV + (size_t)((bh >> 2) * 256 + kb * 8) * 2048 + which * 1024 + (bh & 3) * 256 + d;
        unsigned short e[8];
#pragma unroll
        for (int i = 0; i < 8; ++i) e[i] = src[(size_t)i * 2048];
        v4u o; o.x = e[0] | ((unsigned)e[1] << 16); o.y = e[2] | ((unsigned)e[3] << 16); o.z = e[4] | ((unsigned)e[5] << 16); o.w = e[6] | ((unsigned)e[7] << 16);
        *(GAS v4u*)((bf16*)(ws + (which ? WS_VT : WS_KT)) + (size_t)(bh * 256 + d) * 256 + kb * 8) = o;
    }
}

__device__ __forceinline__ void p2c_onorm(const float* const* in, unsigned char* ws, int gw, int NGW, int lane) {
    const bf16* ZB = (const bf16*)(ws + WS_ZB); bf16* OY = (bf16*)(ws + WS_OY); const float* ng = in[7];
    const float g0 = ng[2 * lane], g1 = ng[2 * lane + 1];
    for (int m = gw; m < M; m += NGW) {
#pragma unroll
        for (int h = 0; h < 4; ++h) {
            const unsigned ow = *(const GAS unsigned*)(OY + (size_t)m * 1024 + h * 128 + 2 * lane); const unsigned zw = *(const GAS unsigned*)(ZB + (size_t)m * 512 + h * 128 + 2 * lane);
            const float o0 = bflo(ow), o1 = bfhi(ow); const float ss = wave_sum(o0 * o0 + o1 * o1);
            const float r = 1.0f / sqrtf(ss * (1.f / 128.f) + EPS);
            *(GAS unsigned*)(OY + (size_t)m * 1024 + h * 128 + 2 * lane) = pk2(o0 * r * g0 * silu_f(bflo(zw)), o1 * r * g1 * silu_f(bfhi(zw)));
        }
    }
}

constexpr int DNA_BYTES = 57344, DNA_W = 0, DNA_KD = 16384, DNA_QG = 32768, DNA_AT = 49152;
constexpr int T1_KN = 0, T1_QN = 17408, T1_VW = 34816, T1_AT = 52224, T1_SM = 61440, T1_BYTES = 62464;
__device__ __forceinline__ unsigned frag_piece_off(int r, int k4, int nks) {
    return (unsigned)((((r >> 4) * nks + (k4 >> 3)) * 64 + (r & 15) + 16 * (k4 & 3)) * 16 + ((k4 >> 2) & 1) * 8);
}
__device__ __forceinline__ void d1_chunk(LAS unsigned char* tl, const float* const* in, unsigned char* ws, int ch, int tt, int lane, int wv) {
    const int c = ch & 63, h = (ch >> 6) & 3, b = ch >> 8;
    const bf16* QKV = (const bf16*)(ws + WS_QKV); const float* AB = (const float*)(ws + WS_AB);
    unsigned char* dna = ws + WS_DNA + (size_t)ch * DNA_BYTES;
    LAS float* SM = (LAS float*)(tl + T1_SM);
    const size_t m0 = (size_t)b * T + (size_t)c * 64;
    {
        const int cg = tt & 15, rg = tt >> 4; const float* conv_w = in[4];
#pragma unroll 1
        for (int X = 0; X < 3; ++X) {
            const int cb = X * 512 + h * 128 + cg * 8;
            f32x4 w[4][2];
#pragma unroll
            for (int jj = 0; jj < 4; ++jj) { w[jj][0] = *(const GAS f32x4*)(conv_w + jj * 1536 + cb); w[jj][1] = *(const GAS f32x4*)(conv_w + jj * 1536 + cb + 4); }
            v4u xr[7];
#pragma unroll
            for (int i = 0; i < 7; ++i) { const int t = c * 64 + 4 * rg - 3 + i;
                if (t >= 0) xr[i] = *(const GAS v4u*)(QKV + ((size_t)b * T + t) * 1536 + cb); else xr[i] = (v4u){0u, 0u, 0u, 0u}; }
#pragma unroll
            for (int rr = 0; rr < 4; ++rr) {
                float o[8];
#pragma unroll
                for (int e = 0; e < 8; ++e) o[e] = 0.f;
#pragma unroll
                for (int jj = 0; jj < 4; ++jj) { float xf[8]; unpack8(xr[rr + jj], xf);
#pragma unroll
                    for (int e = 0; e < 8; ++e) o[e] += w[jj][e >> 2][e & 3] * xf[e]; }
                float ss = 0.f;
#pragma unroll
                for (int e = 0; e < 8; ++e) { o[e] = silu_f(o[e]); ss += o[e] * o[e]; }
                if (X < 2) {
                    ss += __shfl_xor(ss, 1); ss += __shfl_xor(ss, 2); ss += __shfl_xor(ss, 4); ss += __shfl_xor(ss, 8);
                    float r = 1.0f / sqrtf(ss + EPS); if (X == 0) r *= 0.08838834764831845f;
#pragma unroll
                    for (int e = 0; e < 8; ++e) o[e] *= r;
                }
                v4u pk; pk.x = pk2(o[0], o[1]); pk.y = pk2(o[2], o[3]); pk.z = pk2(o[4], o[5]); pk.w = pk2(o[6], o[7]);
                LAS unsigned char* tile = tl + (X == 0 ? T1_QN : (X == 1 ? T1_KN : T1_VW));
                *(LAS v4u*)(tile + (4 * rg + rr) * 272 + cg * 16) = pk;
            }
        }
    }
    if (tt < 64) {
        const float a = AB[(m0 + tt) * 8 + h], bb = AB[(m0 + tt) * 8 + 4 + h];
        const float x = a + in[6][h]; const float sp = fmaxf(x, 0.f) + log1pf(expf(-fabsf(x)));
        const float g = -expf(in[5][h]) * sp; const float beta = 1.0f / (1.0f + expf(-bb));
        float gc = g;
#pragma unroll
        for (int o = 1; o < 64; o <<= 1) { const float t = __shfl_up(gc, o); if (lane >= o) gc += t; }
        const float gl = __shfl(gc, 63);
        SM[tt] = gc; SM[64 + tt] = beta; SM[128 + tt] = expf(gc); SM[192 + tt] = expf(gl - gc);
        if (tt == 0) ((float*)(ws + WS_AL))[ch] = expf(gl);
    }
    __syncthreads();
    const int fr = lane & 15, fq = lane >> 4, it = wv;
    f32x4 akk[4], aqk[4];
#pragma unroll
    for (int jt = 0; jt < 4; ++jt) { akk[jt] = (f32x4){0.f, 0.f, 0.f, 0.f}; aqk[jt] = (f32x4){0.f, 0.f, 0.f, 0.f}; }
#pragma unroll
    for (int ks = 0; ks < 4; ++ks) {
        const bf16x8 ak = *(const LAS bf16x8*)(tl + T1_KN + (16 * it + fr) * 272 + ks * 64 + fq * 16);
        const bf16x8 aq = *(const LAS bf16x8*)(tl + T1_QN + (16 * it + fr) * 272 + ks * 64 + fq * 16);
#pragma unroll
        for (int jt = 0; jt < 4; ++jt) if (jt <= it) {
            const bf16x8 bk = *(const LAS bf16x8*)(tl + T1_KN + (16 * jt + fr) * 272 + ks * 64 + fq * 16);
            akk[jt] = __builtin_amdgcn_mfma_f32_16x16x32_bf16(ak, bk, akk[jt], 0, 0, 0);
            aqk[jt] = __builtin_amdgcn_mfma_f32_16x16x32_bf16(aq, bk, aqk[jt], 0, 0, 0);
        }
    }
#pragma unroll
    for (int n = 0; n < 8; ++n) {
        { const int pid = tt + 256 * n, i = pid >> 5, k4 = pid & 31;
          const v2u qw = *(const LAS v2u*)(tl + T1_QN + i * 272 + k4 * 8); const float e = SM[128 + i];
          v2u o; o.x = pk2(bflo(qw.x) * e, bfhi(qw.x) * e); o.y = pk2(bflo(qw.y) * e, bfhi(qw.y) * e);
          *(GAS v2u*)(dna + DNA_QG + frag_piece_off(i, k4, 4)) = o; }
        { const int pid = tt + 256 * n, dk = pid & 127, i4 = pid >> 7;
          float v[4];
#pragma unroll
          for (int e = 0; e < 4; ++e) v[e] = bf1(*(const LAS bf16*)(tl + T1_KN + (4 * i4 + e) * 272 + dk * 2)) * SM[192 + 4 * i4 + e];
          v2u o; o.x = pk2(v[0], v[1]); o.y = pk2(v[2], v[3]);
          *(GAS v2u*)(dna + DNA_KD + frag_piece_off(dk, i4, 2)) = o; }
    }
    __syncthreads();
    {
        LAS float* L = (LAS float*)(tl + T1_QN);
#pragma unroll
        for (int jt = 0; jt < 4; ++jt) {
            const int j = 16 * jt + fr; const float gj = SM[j];
#pragma unroll
            for (int r = 0; r < 4; ++r) { const int i = 16 * it + 4 * fq + r;
                float lv = 0.f, av = 0.f;
                if (jt <= it && i >= j) { const float dec = __expf(SM[i] - gj); av = aqk[jt][r] * dec; if (i > j) lv = SM[64 + i] * akk[jt][r] * dec; }
                L[i * 68 + j] = lv; *(LAS bf16*)(tl + T1_AT + i * 144 + j * 2) = (bf16)f2bf(av); }
        }
    }
    __syncthreads();
    {
        const int col = 64 * (wv & 1) + lane; const bool isw = wv >= 2;
        const LAS float* L = (const LAS float*)(tl + T1_QN);
        float x[64];
#pragma unroll
        for (int i = 0; i < 64; ++i) { const float bi = SM[64 + i];
            x[i] = isw ? bf1(*(const LAS bf16*)(tl + T1_KN + i * 272 + col * 2)) * bi * SM[128 + i] : bf1(*(const LAS bf16*)(tl + T1_VW + i * 272 + col * 2)) * bi; }
        __syncthreads();
#pragma unroll
        for (int i = 1; i < 64; ++i) {
            float acc = x[i];
#pragma unroll
            for (int k0 = 0; k0 < i; k0 += 4) { const f32x4 l4 = *(const LAS f32x4*)(L + i * 68 + k0);
#pragma unroll
                for (int e = 0; e < 4; ++e) if (k0 + e < i) acc -= l4[e] * x[k0 + e]; }
            x[i] = acc;
        }
        if (!isw) {
            GAS v4u* ut = (GAS v4u*)(ws + WS_UT + (size_t)ch * 16384 + (size_t)col * 128);
#pragma unroll
            for (int i8 = 0; i8 < 8; ++i8) { v4u o; o.x = pk2(x[8 * i8], x[8 * i8 + 1]); o.y = pk2(x[8 * i8 + 2], x[8 * i8 + 3]); o.z = pk2(x[8 * i8 + 4], x[8 * i8 + 5]); o.w = pk2(x[8 * i8 + 6], x[8 * i8 + 7]); ut[i8] = o; }
        } else {
#pragma unroll
            for (int i = 0; i < 64; ++i) *(LAS bf16*)(tl + T1_VW + i * 272 + col * 2) = (bf16)f2bf(-x[i]);
        }
    }
    __syncthreads();
#pragma unroll
    for (int n = 0; n < 8; ++n) { const int pid = tt + 256 * n, i = pid >> 5, k4 = pid & 31;
        *(GAS v2u*)(dna + DNA_W + frag_piece_off(i, k4, 4)) = *(const LAS v2u*)(tl + T1_VW + i * 272 + k4 * 8); }
#pragma unroll
    for (int n = 0; n < 4; ++n) { const int pid = tt + 256 * n, i = pid >> 4, s4 = pid & 15;
        *(GAS v2u*)(dna + DNA_AT + frag_piece_off(i, s4, 2)) = *(const LAS v2u*)(tl + T1_AT + i * 144 + s4 * 8); }
    __syncthreads();
}
__device__ __forceinline__ void d1_phase(LAS unsigned char* lds, const float* const* in, unsigned char* ws, int vcu, int G, int tid, int lane, int wave) {
    const int team = wave >> 2, tt = tid & 255, wv = wave & 3;
    LAS unsigned char* tl = lds + RING_OFF + team * T1_BYTES;
    const int nteams = 2 * G;
    for (int base = 0; base < 1024; base += nteams) {
        int ch = base + 2 * vcu + team; if (ch >= 1024) ch = 1023;
        d1_chunk(tl, in, ws, ch, tt, lane, wv);
    }
}

__device__ __forceinline__ bf16x8 cvt_frag(const f32x4 a, const f32x4 b) {
    v4u w; w.x = pk2(a[0], a[1]); w.y = pk2(a[2], a[3]); w.z = pk2(b[0], b[1]); w.w = pk2(b[2], b[3]); return __builtin_bit_cast(bf16x8, w);
}
__device__ __forceinline__ void d2_dma(LAS unsigned char* buf, const unsigned char* src, int wave, int lane) {
#pragma unroll
    for (int n = 0; n < 7; ++n) { const int p = wave * 7 + n;
        __builtin_amdgcn_global_load_lds((const unsigned*)(src + p * 1024 + lane * 16), (LAS unsigned*)(buf + p * 1024), 16, 0, 0); }
}
__device__ __forceinline__ void d2_phase(LAS unsigned char* lds, unsigned char* ws, int bh, int lane, int wave) {
    const int b = bh >> 2, h = bh & 3, fr = lane & 15, fq = lane >> 4;
    const unsigned char* dna0 = ws + WS_DNA + (size_t)bh * 64 * DNA_BYTES;
    const bf16* ut0 = (const bf16*)(ws + WS_UT) + (size_t)bh * 64 * 8192 + (size_t)(16 * wave + fr) * 64 + 4 * fq;
    const float* AL = (const float*)(ws + WS_AL) + bh * 64;
    bf16* oy = (bf16*)(ws + WS_OY) + ((size_t)b * T + 4 * fq) * 1024 + h * 128 + 16 * wave + fr;
    f32x4 S[8];
#pragma unroll
    for (int mt = 0; mt < 8; ++mt) S[mt] = (f32x4){0.f, 0.f, 0.f, 0.f};
    d2_dma(lds + RING_OFF, dna0, wave, lane);
    v2u utc[4], utn[4];
#pragma unroll
    for (int it = 0; it < 4; ++it) utc[it] = *(const GAS v2u*)(ut0 + 16 * it);
    float alc = AL[0], aln = 0.f;
    asm volatile("s_waitcnt vmcnt(0)" ::: "memory"); __syncthreads();
    for (int c = 0; c < 64; ++c) {
        LAS unsigned char* buf = lds + RING_OFF + (c & 1) * DNA_BYTES;
        if (c + 1 < 64) {
            d2_dma(lds + RING_OFF + ((c + 1) & 1) * DNA_BYTES, dna0 + (size_t)(c + 1) * DNA_BYTES, wave, lane);
#pragma unroll
            for (int it = 0; it < 4; ++it) utn[it] = *(const GAS v2u*)(ut0 + (size_t)(c + 1) * 8192 + 16 * it);
            aln = AL[c + 1];
        }
        bf16x8 sf[4];
#pragma unroll
        for (int ks = 0; ks < 4; ++ks) sf[ks] = cvt_frag(S[2 * ks], S[2 * ks + 1]);
        f32x4 V[4];
#pragma unroll
        for (int it = 0; it < 4; ++it) { V[it] = (f32x4){bflo(utc[it].x), bfhi(utc[it].x), bflo(utc[it].y), bfhi(utc[it].y)};
#pragma unroll
            for (int ks = 0; ks < 4; ++ks) V[it] = __builtin_amdgcn_mfma_f32_16x16x32_bf16(*(const LAS bf16x8*)(buf + DNA_W + ((it * 4 + ks) * 64 + lane) * 16), sf[ks], V[it], 0, 0, 0); }
        bf16x8 vf[2];
#pragma unroll
        for (int k2 = 0; k2 < 2; ++k2) vf[k2] = cvt_frag(V[2 * k2], V[2 * k2 + 1]);
#pragma unroll
        for (int mt = 0; mt < 8; ++mt) { S[mt] = S[mt] * alc;
#pragma unroll
            for (int k2 = 0; k2 < 2; ++k2) S[mt] = __builtin_amdgcn_mfma_f32_16x16x32_bf16(*(const LAS bf16x8*)(buf + DNA_KD + ((mt * 2 + k2) * 64 + lane) * 16), vf[k2], S[mt], 0, 0, 0); }
#pragma unroll
        for (int it = 0; it < 4; ++it) { f32x4 O = (f32x4){0.f, 0.f, 0.f, 0.f};
#pragma unroll
            for (int ks = 0; ks < 4; ++ks) O = __builtin_amdgcn_mfma_f32_16x16x32_bf16(*(const LAS bf16x8*)(buf + DNA_QG + ((it * 4 + ks) * 64 + lane) * 16), sf[ks], O, 0, 0, 0);
#pragma unroll
            for (int k2 = 0; k2 < 2; ++k2) O = __builtin_amdgcn_mfma_f32_16x16x32_bf16(*(const LAS bf16x8*)(buf + DNA_AT + ((it * 2 + k2) * 64 + lane) * 16), vf[k2], O, 0, 0, 0);
#pragma unroll
            for (int r = 0; r < 4; ++r) oy[((size_t)c * 64 + 16 * it + r) * 1024] = (bf16)f2bf(O[r]); }
#pragma unroll
        for (int it = 0; it < 4; ++it) utc[it] = utn[it];
        alc = aln;
        asm volatile("s_waitcnt vmcnt(0)" ::: "memory"); __syncthreads();
    }
}


__device__ __forceinline__ void rms_rows_bf16(const float* src, const float* gain, bf16* dst, int gw, int NGW, int lane) {
    for (int m = gw; m < M; m += NGW) { f32x4 vn[4]; rms_row(src + (size_t)m * D, gain, dst + (size_t)m * D, lane, vn); }
}
__device__ __forceinline__ void rms_rows_f32_inplace(float* buf, const float* gain, int gw, int NGW, int lane) {
    for (int m = gw; m < M; m += NGW) {
        GAS f32x4* xr = (GAS f32x4*)(buf + (size_t)m * D) + lane; const GAS f32x4* gr = (const GAS f32x4*)gain + lane;
        f32x4 v[4]; float s = 0.f;
#pragma unroll
        for (int j = 0; j < 4; ++j) { v[j] = xr[64 * j]; s += (v[j].x * v[j].x + v[j].y * v[j].y) + (v[j].z * v[j].z + v[j].w * v[j].w); }
        const float r = 1.0f / sqrtf(wave_sum(s) * (1.f / 1024.f) + EPS);
#pragma unroll
        for (int j = 0; j < 4; ++j) xr[64 * j] = v[j] * r * gr[64 * j];
    }
}
__device__ __forceinline__ void p7_xattn_naive(LAS unsigned char* lds, unsigned char* ws, int gw, int NGW, int lane, int wave) {
    const bf16* QB = (const bf16*)(ws + WS_QB); const bf16* KT = (const bf16*)(ws + WS_KT); const bf16* VM = (const bf16*)(ws + WS_KV) + 1024; bf16* AO = (bf16*)(ws + WS_AO);
    LAS float* qs = (LAS float*)(lds + RING_OFF + wave * 2048); LAS float* ps = qs + 256;
    for (int it = gw; it < M * 4; it += NGW) {
        const int m = it >> 2, h = it & 3, b = m >> 12;
        { const v2u qw = *(const GAS v2u*)(QB + (size_t)m * 1024 + h * 256 + 4 * lane); *(LAS f32x4*)(qs + 4 * lane) = (f32x4){bflo(qw.x), bfhi(qw.x), bflo(qw.y), bfhi(qw.y)}; }
        LDS_WAIT(); asm volatile("" ::: "memory");
        const bf16* kt = KT + (size_t)(b * 4 + h) * 65536 + 4 * lane;
        f32x4 s = {0.f, 0.f, 0.f, 0.f};
#pragma unroll 4
        for (int d = 0; d < 256; d += 4) { const f32x4 q4 = *(const LAS f32x4*)(qs + d);
#pragma unroll
            for (int e = 0; e < 4; ++e) { const v2u kw = *(const GAS v2u*)(kt + (size_t)(d + e) * 256); const float qv = q4[e];
                s.x += qv * bflo(kw.x); s.y += qv * bfhi(kw.x); s.z += qv * bflo(kw.y); s.w += qv * bfhi(kw.y); } }
        s = s * 0.0625f;
        const float mx = wave_max(fmaxf(fmaxf(s.x, s.y), fmaxf(s.z, s.w)));
        f32x4 pz = {__expf(s.x - mx), __expf(s.y - mx), __expf(s.z - mx), __expf(s.w - mx)};
        const float inv = 1.0f / wave_sum((pz.x + pz.y) + (pz.z + pz.w));
        *(LAS f32x4*)(ps + 4 * lane) = pz * inv;
        LDS_WAIT(); asm volatile("" ::: "memory");
        const bf16* vm = VM + (size_t)b * 256 * 2048 + h * 256 + 4 * lane;
        f32x4 o = {0.f, 0.f, 0.f, 0.f};
#pragma unroll 4
        for (int k = 0; k < 256; k += 4) { const f32x4 p4 = *(const LAS f32x4*)(ps + k);
#pragma unroll
            for (int e = 0; e < 4; ++e) { const v2u vw = *(const GAS v2u*)(vm + (size_t)(k + e) * 2048); const float pv = p4[e];
                o.x += pv * bflo(vw.x); o.y += pv * bfhi(vw.x); o.z += pv * bflo(vw.y); o.w += pv * bfhi(vw.y); } }
        v2u w; w.x = pk2(o.x, o.y); w.y = pk2(o.z, o.w); *(GAS v2u*)(AO + (size_t)m * 1024 + h * 256 + 4 * lane) = w;
        LDS_WAIT(); asm volatile("" ::: "memory");
    }
}

struct Args { const float* in[30]; float* out; unsigned char* ws; int ph_lo, ph_hi, li, pad; };
__global__ void __launch_bounds__(NWAVES * 64, 2) mk_fwd(Args args) {
    extern __shared__ __attribute__((aligned(16))) unsigned char lds_raw[];
    LAS unsigned char* lds = (LAS unsigned char*)lds_raw;
    volatile LAS unsigned* MISC = (volatile LAS unsigned*)(lds + MISC_OFF);
    const int tid = threadIdx.x, lane = tid & 63, wave = __builtin_amdgcn_readfirstlane(tid >> 6);
    const int G = gridDim.x; const int bx = blockIdx.x; const int vcu = (G % 8 == 0) ? (bx % 8) * (G / 8) + bx / 8 : bx;
    unsigned char* ws = args.ws; gu32* ctl = (gu32*)(ws + WS_CTL);
    const float* const* in = args.in; float* out = args.out;
    const int gw = vcu * NWAVES + wave, NGW = G * NWAVES;
    for (int u = tid; u < (LDS_BYTES - LDSCTL_OFF) / 4; u += NWAVES * 64) ((LAS unsigned*)(lds + LDSCTL_OFF))[u] = 0u;
    __syncthreads();
    XcdBarrier bar; bar.bar = (unsigned*)(ctl + CW_BAR); bar.x = 0; bar.st = nullptr;
    if (N_LAUNCHES != PER_PHASE) bar = xcd_barrier_post((unsigned*)(ctl + CW_BAR), MISC + 8);
#define GRID_BAR(seam) do { if (N_LAUNCHES == PER_PHASE) { if (tid == 0) __hip_atomic_store(ctl + CW_TMO, 0xBADBA0u | (unsigned)(seam), RLX_AGENT); } else { xcd_barrier(bar); } } while (0)
    const int lo = args.ph_lo, hi = args.ph_hi;
#ifndef PH_MASK
#define PH_MASK 0x7fff
#endif
#define IN(k) (((PH_MASK >> (k)) & 1) && lo <= (k) && (k) < hi)
#define BOTH(k) (IN(k) && IN((k) + 1))

    if (IN(0)) { p0_prologue(lds, in, ws, vcu, gw, NGW, tid, lane, wave); if (BOTH(0)) GRID_BAR(0); }
    if (IN(1)) {
        pg8::Gemm g{(const pg8::bf16_t*)(ws + WS_XN), (const pg8::bf16_t*)(ws + WS_WIN), D, D, D}; ProjOrder S; S.init(G, bx);
        pg8::EpiProj E{(pg8::bf16_t*)(ws + WS_QKV), (pg8::bf16_t*)(ws + WS_ZB), (pg8::bf16_t*)(ws + WS_UGX), (pg8::bf16_t*)(ws + WS_KV)};
        pg8::gemm_phase<pg8::EpiProj, ProjOrder, true, true>(lds + RING_OFF, g, S, E);
        if (BOTH(1)) GRID_BAR(1);
    }
    if (IN(2)) {
        p2a_prep(ws, gw, NGW, lane);
        { pg8::Gemm g{(const pg8::bf16_t*)(ws + WS_UGX), (const pg8::bf16_t*)(ws + WS_MA), 512, 640, 512}; S5aOrder S{G, bx};
          pg8::EpiXl E{(float*)(ws + WS_XL)};
          pg8::gemm_phase<pg8::EpiXl, S5aOrder, false, true>(lds + RING_OFF, g, S, E); }
        d1_phase(lds, in, ws, vcu, G, tid, lane, wave);
        if (BOTH(2)) GRID_BAR(2);
    }
    if (IN(3)) {
        if (vcu < 16) d2_phase(lds, ws, vcu, lane, wave);
        else if (vcu < 32) s5_scan(ws, (vcu - 16) * 512 + tid);
        else s5_expand(ws, (vcu - 32) * NWAVES + wave, (G - 32) * NWAVES, lane);
        if (BOTH(3)) GRID_BAR(3);
    }
    if (IN(4)) {
        p2c_onorm(in, ws, gw, NGW, lane);
        pg8::Gemm g{(const pg8::bf16_t*)(ws + WS_UGX), (const pg8::bf16_t*)(ws + WS_TZC), 640, 640, 640}; S5cOrder S{G, bx};
        pg8::EpiS5Out E{(const pg8::bf16_t*)(ws + WS_UGX), in[14], (pg8::bf16_t*)(ws + WS_Y0)};
        pg8::gemm_phase<pg8::EpiS5Out, S5cOrder, true, true>(lds + RING_OFF, g, S, E);
        if (BOTH(4)) GRID_BAR(4);
    }
    if (IN(5)) {
        pg8::Gemm g{(const pg8::bf16_t*)(ws + WS_Y0), (const pg8::bf16_t*)(ws + WS_WGLU), 512, 512, 512}; pg8::StaticOrder S; S.init(M, 512, G, bx);
        pg8::EpiGlu E{(const pg8::bf16_t*)(ws + WS_Y0), in[17], (pg8::bf16_t*)(ws + WS_OY)};
        pg8::gemm_phase<pg8::EpiGlu, pg8::StaticOrder, true, true>(lds + RING_OFF, g, S, E);
        if (BOTH(5)) GRID_BAR(5);
    }
    if (IN(6)) {
        pg8::Gemm g{(const pg8::bf16_t*)(ws + WS_OY), (const pg8::bf16_t*)(ws + WS_WOUT), D, D, D}; pg8::StaticOrder S; S.init(M, D, G, bx);
        pg8::EpiResid E{in[0], out};
        pg8::gemm_phase<pg8::EpiResid, pg8::StaticOrder, true, true>(lds + RING_OFF, g, S, E);
        if (BOTH(6)) GRID_BAR(6);
    }
    if (IN(7)) { rms_rows_bf16(out, in[19], (bf16*)(ws + WS_XN), gw, NGW, lane); if (BOTH(7)) GRID_BAR(7); }
    if (IN(8)) {
        pg8::Gemm g{(const pg8::bf16_t*)(ws + WS_XN), (const pg8::bf16_t*)(ws + WS_WXQ), D, D, D}; pg8::StaticOrder S; S.init(M, D, G, bx);
        pg8::EpiBf16 E{(pg8::bf16_t*)(ws + WS_QB), D};
        pg8::gemm_phase<pg8::EpiBf16, pg8::StaticOrder, true, true>(lds + RING_OFF, g, S, E);
        if (BOTH(8)) GRID_BAR(8);
    }
    if (IN(9)) { p7_xattn_naive(lds, ws, gw, NGW, lane, wave); if (BOTH(9)) GRID_BAR(9); }
    if (IN(10)) {
        pg8::Gemm g{(const pg8::bf16_t*)(ws + WS_AO), (const pg8::bf16_t*)(ws + WS_WXO), D, D, D}; pg8::StaticOrder S; S.init(M, D, G, bx);
        pg8::EpiResid E{out, out};
        pg8::gemm_phase<pg8::EpiResid, pg8::StaticOrder, true, true>(lds + RING_OFF, g, S, E);
        if (BOTH(10)) GRID_BAR(10);
    }
    if (IN(11)) { rms_rows_bf16(out, in[25], (bf16*)(ws + WS_XN), gw, NGW, lane); if (BOTH(11)) GRID_BAR(11); }
    if (IN(12)) {
        pg8::Gemm g{(const pg8::bf16_t*)(ws + WS_XN), (const pg8::bf16_t*)(ws + WS_WGU), D, D, D}; pg8::StaticOrder S; S.init(M, NGU, G, bx);
        pg8::EpiSwiGlu E{(pg8::bf16_t*)(ws + WS_HID)};
        pg8::gemm_phase<pg8::EpiSwiGlu, pg8::StaticOrder, true, true>(lds + RING_OFF, g, S, E);
        if (BOTH(12)) GRID_BAR(12);
    }
    if (IN(13)) {
        pg8::Gemm g{(const pg8::bf16_t*)(ws + WS_HID), (const pg8::bf16_t*)(ws + WS_WDN), DFF, DFF, DFF}; pg8::StaticOrder S; S.init(M, D, G, bx);
        pg8::EpiResid E{out, out};
        pg8::gemm_phase<pg8::EpiResid, pg8::StaticOrder, true, true>(lds + RING_OFF, g, S, E);
        if (BOTH(13)) GRID_BAR(13);
    }
    if (IN(14)) { rms_rows_f32_inplace(out, in[29], gw, NGW, lane); }
#undef IN
#undef BOTH
}

extern "C" void kernel_launch(void* const* d_in, const int* in_sizes, int n_in, void* d_out, int out_size, void* d_ws, size_t ws_size, hipStream_t stream) {
    static int grid = 0;
    if (grid == 0) {
        if (n_in != 30 || in_sizes[0] != M * D || out_size != M * D || ws_size < WS_END) { fprintf(stderr, "kernel_launch: unexpected shapes (n_in %d, in0 %d, out %d, ws %zu); nothing launched\n", n_in, n_in > 0 ? in_sizes[0] : -1, out_size, ws_size); grid = -1; return; }
        int dev = 0, cus = 0, per_cu = 0;
        if (hipGetDevice(&dev) != hipSuccess || hipDeviceGetAttribute(&cus, hipDeviceAttributeMultiprocessorCount, dev) != hipSuccess) { grid = -1; return; }
        if (hipFuncSetAttribute((const void*)mk_fwd, hipFuncAttributeMaxDynamicSharedMemorySize, LDS_BYTES) != hipSuccess) { fprintf(stderr, "kernel_launch: hipFuncSetAttribute failed\n"); grid = -1; return; }
        if (hipOccupancyMaxActiveBlocksPerMultiprocessor(&per_cu, (const void*)mk_fwd, NWAVES * 64, LDS_BYTES) != hipSuccess || per_cu < 1) { fprintf(stderr, "kernel_launch: occupancy query reports %d workgroups per CU\n", per_cu); per_cu = 1; }
        (void)hipGetLastError();
        grid = cus;
    }
    if (grid < 0) return;
    if (hipMemsetAsync((char*)d_ws + WS_CTL, 0, CTL_ZERO_BYTES, stream) != hipSuccess) { fprintf(stderr, "kernel_launch: hipMemsetAsync failed\n"); return; }
    Args a{};
    for (int i = 0; i < 30; ++i) a.in[i] = (const float*)d_in[i];
    a.out = (float*)d_out; a.ws = (unsigned char*)d_ws;
    constexpr int NPH = 15;
    if (N_LAUNCHES == 1) { a.ph_lo = 0; a.ph_hi = NPH; a.li = 0; hipLaunchKernelGGL(mk_fwd, dim3(grid), dim3(NWAVES * 64), LDS_BYTES, stream, a); }
    else for (int li = 0; li < NPH; ++li) { a.ph_lo = li; a.ph_hi = li + 1; a.li = 0; hipLaunchKernelGGL(mk_fwd, dim3(grid), dim3(NWAVES * 64), LDS_BYTES, stream, a); }
    const hipError_t le = hipPeekAtLastError();
    if (le != hipSuccess) fprintf(stderr, "kernel_launch: launch failed: %s\n", hipGetErrorName(le));
}
```
